# Optimizing an MI355X kernel written in HIP

```python
import math
import jax, jax.numpy as jnp
from jax import lax
import numpy as np

D_MODEL = 1024
BATCH = 2
SEQ = 8192
DEPTH = 1

HEAD_DIM = 64
MIX_WIDTH = D_MODEL
DIFF_VDIM = 2 * HEAD_DIM
DIFF_HEADS = (MIX_WIDTH // 2) // DIFF_VDIM
SB_HEADS = (MIX_WIDTH // 2) // HEAD_DIM
DIFF_QK = DIFF_HEADS * 2 * HEAD_DIM
DIFF_V = DIFF_HEADS * DIFF_VDIM
SB_W = SB_HEADS * HEAD_DIM
IN_COLS = 2 * DIFF_QK + DIFF_V + 3 * SB_W
Q_BLOCK = 128
N_GROUPS = 4
EXPERTS_PER_GROUP = 8
TOP_K_IN_GROUP = 2
D_EXPERT = 256
N_MOD = 6
EPS = 1e-6

kernel_name = "hymba_diff_stickbreak_hmoe_block"


def rms_norm(x, g):
    xf = x.astype(jnp.float32)
    y = xf * lax.rsqrt(jnp.mean(xf * xf, axis=-1, keepdims=True) + EPS)
    return (y * g.astype(jnp.float32)).astype(x.dtype)


def modulate(h, shift, scale):
    return h * (1.0 + scale[:, None, :]) + shift[:, None, :]


def alibi_slopes(n_heads):
    return 2.0 ** (-8.0 * jnp.arange(1, n_heads + 1, dtype=jnp.float32) / n_heads)


def diff_attention(q, k, v, lam):
    B, H, _, S, d = q.shape
    nb = S // Q_BLOCK
    slopes = alibi_slopes(H)
    spos = jnp.arange(S)
    qb = q.reshape(B, H, 2, nb, Q_BLOCK, d).transpose(3, 0, 1, 2, 4, 5)

    def one_block(args):
        q_blk, i = args
        tpos = i * Q_BLOCK + jnp.arange(Q_BLOCK)
        dist = tpos[:, None] - spos[None, :]
        s = jnp.einsum('bhmqd,bhmkd->bhmqk', q_blk, k).astype(jnp.float32)
        bias = -slopes[:, None, None, None] * dist.astype(jnp.float32)
        s = jnp.where(dist >= 0, s + bias, -jnp.inf)
        p = jax.nn.softmax(s, axis=-1)
        a = p[:, :, 0] - lam * p[:, :, 1]
        return jnp.einsum('bhqk,bhkd->bhqd', a.astype(v.dtype), v)

    out = lax.map(one_block, (qb, jnp.arange(nb)))
    return out.transpose(1, 0, 3, 2, 4).reshape(B, S, H, v.shape[-1])


def stick_breaking_attention(q, k, v):
    B, H, S, d = q.shape
    nb = S // Q_BLOCK
    scale = 1.0 / math.sqrt(d)
    spos = jnp.arange(S)
    qb = q.reshape(B, H, nb, Q_BLOCK, d).transpose(2, 0, 1, 3, 4)

    def one_block(args):
        q_blk, i = args
        tpos = i * Q_BLOCK + jnp.arange(Q_BLOCK)
        mask = spos[None, :] < tpos[:, None]
        z = jnp.einsum('bhqd,bhkd->bhqk', q_blk, k).astype(jnp.float32) * scale
        log_beta = jax.nn.log_sigmoid(z)
        log_rem = jnp.where(mask, jax.nn.log_sigmoid(-z), 0.0)
        suffix = lax.cumsum(log_rem, axis=3, reverse=True) - log_rem
        a = jnp.where(mask, jnp.exp(log_beta + suffix), 0.0)
        return jnp.einsum('bhqk,bhkd->bhqd', a.astype(v.dtype), v)

    out = lax.map(one_block, (qb, jnp.arange(nb)))
    return out.transpose(1, 0, 3, 2, 4).reshape(B, S, H, d)


def hier_moe(h, w_group, b_group, w_erouter, b_expert, w1, w3, w2):
    B, S, D = h.shape
    ht = h.reshape(B * S, D)
    g_logits = (ht @ w_group + b_group).astype(jnp.float32)
    p_group = jax.nn.softmax(g_logits, axis=-1)
    _, g_sel = lax.top_k(g_logits, 1)
    gate_group = jnp.take_along_axis(p_group, g_sel, axis=-1)
    g_sel = g_sel[:, 0]
    e_all = (jnp.einsum('td,gde->tge', ht, w_erouter) + b_expert).astype(jnp.float32)
    e_logits = jnp.take_along_axis(e_all, g_sel[:, None, None], axis=1)[:, 0]
    top_vals, top_idx = lax.top_k(e_logits, TOP_K_IN_GROUP)
    top_w = jax.nn.softmax(top_vals, axis=-1)
    within = jnp.sum(jax.nn.one_hot(top_idx, EXPERTS_PER_GROUP, dtype=jnp.float32)
                     * top_w[..., None], axis=1)
    combine = (gate_group[:, :, None]
               * jax.nn.one_hot(g_sel, N_GROUPS, dtype=jnp.float32)[:, :, None]
               * within[:, None, :]).astype(ht.dtype)
    out = jnp.zeros_like(ht)
    for g in range(N_GROUPS):
        hg = jax.nn.silu(jnp.einsum('td,edf->tef', ht, w1[g])) * jnp.einsum('td,edf->tef', ht, w3[g])
        out = out + jnp.einsum('tef,efd->td', hg * combine[:, g, :, None], w2[g])
    return out.reshape(B, S, D)


def setup_inputs(seed: int = 0) -> dict:
    key = jax.random.key(seed)
    ks = jax.random.split(key, 24)
    f32 = jnp.float32
    L, D, d = DEPTH, D_MODEL, HEAD_DIM
    G, E, F = N_GROUPS, EXPERTS_PER_GROUP, D_EXPERT
    nrm = lambda k, shape, s: jax.random.normal(k, shape, f32) * s
    return {
        "x": nrm(ks[0], (BATCH, SEQ, D), 1.0),
        "c": nrm(ks[1], (BATCH, D), 1.0),
        "w_ada": nrm(ks[2], (L, D, N_MOD * D), 0.5 * D ** -0.5),
        "b_ada": nrm(ks[3], (L, N_MOD * D), 0.02),
        "g_attn": 1.0 + nrm(ks[4], (L, D), 0.05),
        "w_in": nrm(ks[5], (L, D, IN_COLS), D ** -0.5),
        "q_norm_g": 1.0 + nrm(ks[6], (L, d), 0.05),
        "k_norm_g": 1.0 + nrm(ks[7], (L, d), 0.05),
        "lambda_q1": nrm(ks[8], (L, d), 0.1),
        "lambda_k1": nrm(ks[9], (L, d), 0.1),
        "lambda_q2": nrm(ks[10], (L, d), 0.1),
        "lambda_k2": nrm(ks[11], (L, d), 0.1),
        "diff_out_g": 1.0 + nrm(ks[12], (L, DIFF_VDIM), 0.05),
        "sb_out_g": 1.0 + nrm(ks[13], (L, d), 0.05),
        "w_out": nrm(ks[14], (L, MIX_WIDTH, D), MIX_WIDTH ** -0.5),
        "g_ffn": 1.0 + nrm(ks[15], (L, D), 0.05),
        "w_group": nrm(ks[16], (L, D, G), D ** -0.5),
        "b_group": nrm(ks[17], (L, G), 0.01),
        "w_erouter": nrm(ks[18], (L, G, D, E), D ** -0.5),
        "b_expert": nrm(ks[19], (L, G, E), 0.01),
        "w1": nrm(ks[20], (L, G, E, D, F), D ** -0.5),
        "w3": nrm(ks[21], (L, G, E, D, F), D ** -0.5),
        "w2": nrm(ks[22], (L, G, E, F, D), F ** -0.5),
    }


def reference(x, c, w_ada, b_ada, g_attn, w_in, q_norm_g, k_norm_g,
              lambda_q1, lambda_k1, lambda_q2, lambda_k2, diff_out_g, sb_out_g,
              w_out, g_ffn, w_group, b_group, w_erouter, b_expert, w1, w3, w2):
    B, S, D = x.shape
    d = HEAD_DIM
    qk_scale = 1.0 / math.sqrt(d)
    for layer in range(DEPTH):
        lambda_init = 0.8 - 0.6 * math.exp(-0.3 * layer)
        mod = jax.nn.silu(c) @ w_ada[layer] + b_ada[layer]
        sh_a, sc_a, gt_a, sh_f, sc_f, gt_f = jnp.split(mod, N_MOD, axis=-1)

        h = modulate(rms_norm(x, g_attn[layer]), sh_a, sc_a)
        proj = h @ w_in[layer]
        cuts = np.cumsum([DIFF_QK, DIFF_QK, DIFF_V, SB_W, SB_W])
        dq, dk, dv, sq, sk, sv = jnp.split(proj, cuts.tolist(), axis=-1)

        dq = dq.reshape(B, S, DIFF_HEADS, 2, d).transpose(0, 2, 3, 1, 4)
        dk = dk.reshape(B, S, DIFF_HEADS, 2, d).transpose(0, 2, 3, 1, 4)
        dq = rms_norm(dq, q_norm_g[layer]) * qk_scale
        dk = rms_norm(dk, k_norm_g[layer])
        dv = dv.reshape(B, S, DIFF_HEADS, DIFF_VDIM).transpose(0, 2, 1, 3)
        lam = (jnp.exp(jnp.sum(lambda_q1[layer] * lambda_k1[layer]).astype(jnp.float32))
               - jnp.exp(jnp.sum(lambda_q2[layer] * lambda_k2[layer]).astype(jnp.float32))
               + lambda_init)
        a_out = diff_attention(dq, dk, dv, lam)
        a_out = rms_norm(a_out, diff_out_g[layer]) * (1.0 - lambda_init)
        a_out = a_out.reshape(B, S, DIFF_V)

        sq = sq.reshape(B, S, SB_HEADS, d).transpose(0, 2, 1, 3)
        sk = sk.reshape(B, S, SB_HEADS, d).transpose(0, 2, 1, 3)
        sv = sv.reshape(B, S, SB_HEADS, d).transpose(0, 2, 1, 3)
        b_out = stick_breaking_attention(sq, sk, sv)
        b_out = rms_norm(b_out, sb_out_g[layer]).reshape(B, S, SB_W)

        y = jnp.concatenate([a_out, b_out], axis=-1) @ w_out[layer]
        x = x + gt_a[:, None, :] * y

        h = modulate(rms_norm(x, g_ffn[layer]), sh_f, sc_f)
        y = hier_moe(h, w_group[layer], b_group[layer], w_erouter[layer], b_expert[layer],
                     w1[layer], w3[layer], w2[layer])
        x = x + gt_f[:, None, :] * y
    return x
```

```cpp
#include <hip/hip_runtime.h>
#include <hip/hip_bf16.h>
#include <cstdio>
#include <cstdint>
#include <cmath>

#define LAS __attribute__((address_space(3)))
#define GAS __attribute__((address_space(1)))
typedef unsigned short bf16_t;
typedef short bf16x8 __attribute__((ext_vector_type(8)));
typedef short s16x4 __attribute__((ext_vector_type(4)));
typedef _Float16 f16x8 __attribute__((ext_vector_type(8)));
typedef _Float16 f16x2 __attribute__((ext_vector_type(2)));
typedef float f32x4 __attribute__((ext_vector_type(4)));
typedef float f32x2 __attribute__((ext_vector_type(2)));
typedef float f32x16 __attribute__((ext_vector_type(16)));
typedef unsigned u32x4 __attribute__((ext_vector_type(4)));
typedef unsigned u32x2 __attribute__((ext_vector_type(2)));
typedef __bf16 bf16x2_t __attribute__((ext_vector_type(2)));

__device__ __forceinline__ unsigned cvtpk(float lo, float hi) { f32x2 v = {lo, hi}; bf16x2_t b = __builtin_convertvector(v, bf16x2_t); return __builtin_bit_cast(unsigned, b); }

namespace pg8 {
constexpr int BM = 256, BK = 64, HALF = 128, HTB = HALF * BK * 2, STAGE_BYTES = 8 * HTB, NXCD = 8, WGM = 8;
__host__ __device__ __forceinline__ int lds_byte(int r, int c) { const int st = (r >> 4) * 2 + (c >> 5), rr = r & 15, cc = c & 31, ob = rr * 64 + cc * 2; return st * 1024 + (ob ^ (((ob >> 9) & 1) << 5)); }
__host__ __device__ __forceinline__ void stage_rc(int b, int& R, int& C) { const int st = b / 1024, sb = b % 1024, swz = sb ^ (((sb >> 9) & 1) << 5); R = (st >> 1) * 16 + swz / 64; C = (st & 1) * 32 + (swz % 64) / 2; }
__host__ __device__ __forceinline__ int perm32(int rho) { const int n = rho >> 4, i = rho & 15; return 8 * (i >> 2) + 4 * n + (i & 3); }

struct Unit { int pm, pn; const char* a; const char* b; int e, loc0, cnt, pad; };


template <class Epi, class Sched, bool ALIGN_EPI = false>
__device__ __forceinline__ void gemm_phase(LAS unsigned char* lds, const int K, const Sched& S, const Epi& E) {
    const int tid = threadIdx.x, wid = __builtin_amdgcn_readfirstlane(tid >> 6), lane = tid & 63, wr = wid >> 2, wc = wid & 3, fr = lane & 15, fq = lane >> 4;
    const int nt = K / BK;
    Unit cur, nxt; int ui = 0;
    if (!S.next(0, cur)) return;
    int sR[2], sC[2];
#pragma unroll
    for (int i = 0; i < 2; ++i) stage_rc(tid * 16 + i * 8192, sR[i], sC[i]);
    unsigned vB[2][2], vA[2][2];
    LAS unsigned* xoff = (LAS unsigned*)(lds + 131072 + 2048) + tid * 4;
#pragma unroll
    for (int h = 0; h < 2; ++h)
#pragma unroll
        for (int i = 0; i < 2; ++i) { vB[h][i] = S.offB(h, sR[i], sC[i]); vA[h][i] = S.offA(cur, h, sR[i], sC[i]); }
    const size_t kstep = (size_t)(BK * 2);
    const unsigned ldsw = (unsigned)wid * 1024u;
    const int aoff = lds_byte(wr * 64 + fr, fq * 8), boff = lds_byte(wc * 32 + fr, fq * 8);
#define PG8_SA(b, h) (((b) * 2 + (h)) * HTB)
#define PG8_SB(b, h) ((4 + (b) * 2 + (h)) * HTB)
#define PG8_STAGE(bufoff, gbase, o0, o1) do { \
        __builtin_amdgcn_global_load_lds((const unsigned*)((const char*)(gbase) + (o0)), (LAS unsigned*)(lds + (bufoff) + ldsw), 16, 0, 0); \
        __builtin_amdgcn_global_load_lds((const unsigned*)((const char*)(gbase) + (o1)), (LAS unsigned*)(lds + (bufoff) + ldsw + 8192), 16, 0, 0); } while (0)
#define PG8_STA(bufoff, gbase, V, h) PG8_STAGE(bufoff, gbase, V[h][0], V[h][1])
#define PG8_LDA(dst, b, h) do { _Pragma("unroll") for (int m = 0; m < 4; ++m) _Pragma("unroll") for (int k = 0; k < 2; ++k) dst[m][k] = *(const LAS bf16x8*)(lds + PG8_SA(b, h) + aoff + m * 2048 + k * 1024); } while (0)
#define PG8_LDB(dst, b, h) do { _Pragma("unroll") for (int n = 0; n < 2; ++n) _Pragma("unroll") for (int k = 0; k < 2; ++k) dst[n][k] = *(const LAS bf16x8*)(lds + PG8_SB(b, h) + boff + n * 2048 + k * 1024); } while (0)
#define PG8_MMA(ai, bj, At, Bt) do { __builtin_amdgcn_s_setprio(1); _Pragma("unroll") for (int m = 0; m < 4; ++m) _Pragma("unroll") for (int n = 0; n < 2; ++n) _Pragma("unroll") for (int k = 0; k < 2; ++k) \
        acc[ai][bj][m][n] = __builtin_amdgcn_mfma_f32_16x16x32_bf16(Bt[n][k], At[m][k], acc[ai][bj][m][n], 0, 0, 0); __builtin_amdgcn_s_setprio(0); } while (0)
#define PG8_WAIT_V(n) asm volatile("s_waitcnt vmcnt(" #n ")" ::: "memory")
#define PG8_WAIT_L(n) asm volatile("s_waitcnt lgkmcnt(" #n ")" ::: "memory")
#define PG8_BAR __builtin_amdgcn_s_barrier()
#define PG8_SCHED __builtin_amdgcn_sched_barrier(0)
    f32x4 acc[2][2][4][2];
#pragma unroll
    for (int a = 0; a < 2; ++a)
#pragma unroll
        for (int b = 0; b < 2; ++b)
#pragma unroll
            for (int m = 0; m < 4; ++m)
#pragma unroll
                for (int n = 0; n < 2; ++n) acc[a][b][m][n] = (f32x4){0.f, 0.f, 0.f, 0.f};
    bf16x8 At[4][2], B0[2][2], B1[2][2];
    const char* cA = cur.a; const char* cB = cur.b;
    PG8_STA(PG8_SB(0, 0), cB, vB, 0); PG8_STA(PG8_SB(0, 1), cB, vB, 1); PG8_STA(PG8_SA(0, 0), cA, vA, 0); PG8_STA(PG8_SA(0, 1), cA, vA, 1);
    if (wr == 1) PG8_BAR;
    PG8_WAIT_V(2); PG8_BAR;
    PG8_STA(PG8_SB(1, 0), cB + kstep, vB, 0); PG8_STA(PG8_SA(1, 0), cA + kstep, vA, 0); PG8_STA(PG8_SB(1, 1), cB + kstep, vB, 1);
    PG8_WAIT_V(6); PG8_BAR;
    for (;;) {
        const bool has_next = S.next(ui + 1, nxt);
        const char* nA = has_next ? nxt.a : cA; const char* nB = has_next ? nxt.b : cB;
        if (Sched::GATHER) {
            if (has_next) {
#pragma unroll
                for (int i = 0; i < 2; ++i) { int t_ = tid; asm volatile("" : "+v"(t_)); int R_, C_; stage_rc(t_ * 16 + i * 8192, R_, C_);
#pragma unroll
                    for (int h = 0; h < 2; ++h) xoff[h * 2 + i] = S.offA(nxt, h, R_, C_); }
            }
        }
        for (int t = 0; t < nt; t += 2) {
            const bool last = (t == nt - 2);
            const char* a1 = cA + (size_t)(t + 1) * kstep;
            const char* a2 = last ? nA : cA + (size_t)(t + 2) * kstep; const char* b2 = last ? nB : cB + (size_t)(t + 2) * kstep;
            const char* a3 = a2 + kstep; const char* b3 = b2 + kstep;
            PG8_LDB(B0, 0, 0); PG8_LDB(B1, 0, 1); PG8_SCHED; PG8_LDA(At, 0, 0); PG8_STA(PG8_SA(1, 1), a1, vA, 1);
            PG8_WAIT_V(8); PG8_WAIT_L(0); PG8_BAR; PG8_MMA(0, 0, At, B0); PG8_MMA(0, 1, At, B1); PG8_BAR; PG8_SCHED;
            if (Sched::GATHER) { if (last && has_next) { vA[0][0] = xoff[0]; vA[0][1] = xoff[1]; vA[1][0] = xoff[2]; vA[1][1] = xoff[3]; } }
            PG8_LDA(At, 0, 1); PG8_STA(PG8_SB(0, 0), b2, vB, 0); PG8_STA(PG8_SB(0, 1), b2, vB, 1); PG8_STA(PG8_SA(0, 0), a2, vA, 0);
            PG8_WAIT_V(8); PG8_WAIT_L(0); PG8_BAR; PG8_MMA(1, 0, At, B0); PG8_MMA(1, 1, At, B1); PG8_BAR; PG8_SCHED;
            PG8_LDB(B0, 1, 0); PG8_LDB(B1, 1, 1); PG8_SCHED; PG8_LDA(At, 1, 0); PG8_STA(PG8_SA(0, 1), a2, vA, 1);
            PG8_WAIT_V(8); PG8_WAIT_L(0); PG8_BAR; PG8_MMA(0, 0, At, B0); PG8_MMA(0, 1, At, B1); PG8_BAR; PG8_SCHED;
            PG8_LDA(At, 1, 1); PG8_STA(PG8_SB(1, 0), b3, vB, 0); PG8_STA(PG8_SB(1, 1), b3, vB, 1); PG8_STA(PG8_SA(1, 0), a3, vA, 0);
            PG8_WAIT_V(8); PG8_WAIT_L(0); PG8_BAR; PG8_MMA(1, 0, At, B0); PG8_MMA(1, 1, At, B1); PG8_BAR; PG8_SCHED;
        }
        if constexpr (ALIGN_EPI) { if (wr == 0) PG8_BAR; }
        E(acc, cur, wr, wc, fr, fq);
        if (!has_next) break;
#pragma unroll
        for (int a = 0; a < 2; ++a)
#pragma unroll
            for (int b = 0; b < 2; ++b)
#pragma unroll
                for (int m = 0; m < 4; ++m)
#pragma unroll
                    for (int n = 0; n < 2; ++n) acc[a][b][m][n] = (f32x4){0.f, 0.f, 0.f, 0.f};
        cur = nxt; cA = nA; cB = nB; ++ui;
        if constexpr (ALIGN_EPI) { if (wr == 1) PG8_BAR; }
    }
    PG8_WAIT_V(0);
    if constexpr (!ALIGN_EPI) { if (wr == 0) PG8_BAR; }
    PG8_BAR;
#undef PG8_SA
#undef PG8_SB
#undef PG8_STAGE
#undef PG8_STA
#undef PG8_LDA
#undef PG8_LDB
#undef PG8_MMA
#undef PG8_WAIT_V
#undef PG8_WAIT_L
#undef PG8_BAR
#undef PG8_SCHED
}
}

constexpr int BATCH = 2, SEQ = 8192, DM = 1024, MTOK = BATCH * SEQ, INC = 3072;
constexpr int NEXP = 32, DEXP = 256, NWAVES = 8;
constexpr float EPS = 1e-6f, LOG2E = 1.4426950408889634f;
constexpr float LAMBDA_INIT = 0.2f;
constexpr int MAXTILES = 160, MAXSLOTS = MAXTILES * 256;

constexpr size_t MiB = 1u << 20;
constexpr size_t WS_CTL = 0, CTL_ZERO_BYTES = 64 * 1024;
constexpr size_t WS_MODV = 1 * MiB;
constexpr size_t WS_WR = 1 * MiB + 256 * 1024;
constexpr size_t WS_WIN = 2 * MiB;
constexpr size_t WS_WOUT = 8 * MiB;
constexpr size_t WS_W13 = 10 * MiB;
constexpr size_t WS_W2 = 42 * MiB;
constexpr size_t WS_HB = 58 * MiB;
constexpr size_t WS_QD = 90 * MiB, WS_KD = 106 * MiB, WS_VD = 122 * MiB, WS_QS = 138 * MiB, WS_KS = 154 * MiB, WS_VS = 170 * MiB;
constexpr size_t WS_AO = 186 * MiB;
constexpr size_t WS_ROUTE = 218 * MiB;
constexpr size_t WS_LIST = WS_ROUTE + 256 * 1024, WS_LISTW = WS_LIST + 2 * MiB;
constexpr size_t WS_HG = 90 * MiB;
constexpr size_t WS_Y = 110 * MiB;
constexpr size_t WS_END = 224 * MiB;
static_assert(WS_HG + (size_t)MAXSLOTS * 256 * 2 <= WS_Y && WS_Y + (size_t)MAXSLOTS * 1024 * 2 <= WS_ROUTE && WS_LISTW + 2 * MiB <= WS_END, "ws map");
constexpr int CW_CNT = 64;
constexpr int CW_BAR = 4096;

constexpr int RING_OFF = 0, RING_BYTES = 131072;
constexpr int LDSCTL_OFF = RING_BYTES, MISC_OFF = LDSCTL_OFF + 320;
constexpr int TPRE_OFF = LDSCTL_OFF + 1024;
constexpr int LDS_BYTES = 147456;

typedef GAS unsigned gu32;
#define RLX_AGENT __ATOMIC_RELAXED, __HIP_MEMORY_SCOPE_AGENT
#define LDS_WAIT() asm volatile("s_waitcnt lgkmcnt(0)" ::: "memory")
#define VM_WAIT() asm volatile("s_waitcnt vmcnt(0)" ::: "memory")

#define XB_TMO      128
#define XB_XCNT(j)  (256  + 64 * (j))
#define XB_XSUB(j)  (1280 + 64 * (j))
#define XB_XGEN(j)  (2304 + 64 * (j))
#define XB_TOP      3328
#define XB_TOPGEN   3392
#define XCD_BAR_WORDS 3456
#define XB_SPIN_CAP (1u << 20)
__device__ __forceinline__ unsigned xb_ld(unsigned* p)              { return __hip_atomic_load(p, __ATOMIC_RELAXED, __HIP_MEMORY_SCOPE_AGENT); }
__device__ __forceinline__ unsigned xb_add(unsigned* p, unsigned v) { return __hip_atomic_fetch_add(p, v, __ATOMIC_RELAXED, __HIP_MEMORY_SCOPE_AGENT); }
__device__ __forceinline__ unsigned xb_xcc_id() { return (unsigned)__builtin_amdgcn_s_getreg((3 << 11) | 20) & 0xFu; }
#define XB_SPIN(cond, bar) do { unsigned _sp = 0; while (cond) { __builtin_amdgcn_s_sleep(1); \
    if ((++_sp & 255u) == 0u) { if (xb_ld(&(bar)[XB_TMO])) break; if (_sp > XB_SPIN_CAP) { atomicAdd(&(bar)[XB_TMO], 1u); break; } } } } while (0)
struct XcdBarrier { unsigned* bar; unsigned x; volatile LAS unsigned* st; };
__device__ __forceinline__ XcdBarrier xcd_barrier_post(unsigned* bar, volatile LAS unsigned* st) {
    XcdBarrier b; b.bar = bar; b.x = xb_xcc_id(); b.st = st;
    if (threadIdx.x == 0) (void)xb_add(&bar[XB_XCNT(b.x)], 1u);
    return b;
}
__device__ __forceinline__ void xcd_barrier_complete(unsigned* bar, unsigned x, unsigned& nloc, unsigned& nx) {
    const unsigned G = gridDim.x * gridDim.y * gridDim.z;
    unsigned sum, cnt, mine, sp = 0u;
    for (;;) {
        sum = 0u; cnt = 0u; mine = 0u;
#pragma unroll
        for (unsigned j = 0; j < 16; ++j) { const unsigned c = xb_ld(&bar[XB_XCNT(j)]); sum += c; cnt += (c > 0u) ? 1u : 0u; mine = (j == x) ? c : mine; }
        if (sum == G) break;
        __builtin_amdgcn_s_sleep(1);
        if ((++sp & 255u) == 0u) { if (xb_ld(&bar[XB_TMO])) break; if (sp > XB_SPIN_CAP) { atomicAdd(&bar[XB_TMO], 1u); break; } }
    }
    nloc = mine > 0u ? mine : 1u; nx = cnt > 0u ? cnt : 1u;
}
__device__ __forceinline__ void xcd_barrier(const XcdBarrier& b) {
    asm volatile("s_waitcnt vmcnt(0)" ::: "memory");
    __syncthreads();
    if (threadIdx.x == 0) {
        unsigned* bar = b.bar;
        __builtin_amdgcn_s_waitcnt(0);
        unsigned nloc = b.st[0], nx = b.st[1];
        if (nloc == 0u) { xcd_barrier_complete(bar, b.x, nloc, nx); b.st[0] = nloc; b.st[1] = nx; }
        const unsigned old = xb_add(&bar[XB_XSUB(b.x)], 1u);
        const unsigned gen = old / nloc;
        if (old + 1u == (gen + 1u) * nloc) {
            __builtin_amdgcn_fence(__ATOMIC_RELEASE, "agent");
            asm volatile("s_waitcnt vmcnt(0)" ::: "memory");
            const unsigned og = xb_add(&bar[XB_TOP], 1u);
            const unsigned tg = og / nx;
            if (og + 1u == (tg + 1u) * nx) xb_add(&bar[XB_TOPGEN], 1u);
            else XB_SPIN(xb_ld(&bar[XB_TOPGEN]) == tg, bar);
            __builtin_amdgcn_fence(__ATOMIC_ACQUIRE, "agent");
            xb_add(&bar[XB_XGEN(b.x)], 1u);
            asm volatile("s_waitcnt vmcnt(0)" ::: "memory");
        } else {
            XB_SPIN(xb_ld(&bar[XB_XGEN(b.x)]) == gen, bar);
            __builtin_amdgcn_fence(__ATOMIC_ACQUIRE, "agent");
            asm volatile("s_waitcnt vmcnt(0)" ::: "memory");
        }
    }
    __syncthreads();
}

__device__ __forceinline__ float wave_sum(float v) {
#pragma unroll
    for (int o = 1; o < 64; o <<= 1) v += __shfl_xor(v, o);
    return v;
}
__device__ __forceinline__ float wave_max(float v) {
#pragma unroll
    for (int o = 1; o < 64; o <<= 1) v = fmaxf(v, __shfl_xor(v, o));
    return v;
}
__device__ __forceinline__ unsigned f2bf(float f) { unsigned u = __builtin_bit_cast(unsigned, f); return (u + 0x7fffu + ((u >> 16) & 1u)) >> 16; }
__device__ __forceinline__ unsigned pk2(float lo, float hi) { return f2bf(lo) | (f2bf(hi) << 16); }
__device__ __forceinline__ float bf2f(unsigned short h) { return __builtin_bit_cast(float, (unsigned)h << 16); }

struct DenseSched {
    static constexpr bool GATHER = false;
    int nM, nN, nwg, G, c, K; const char* A; const char* B; int bmode;
    bool perm;
    __device__ __forceinline__ bool next(int i, pg8::Unit& u) const {
        const long L = (long)i * G + c; if (L >= nwg) return false;
        int wgid = (int)L; { const int q = nwg / pg8::NXCD, r = nwg % pg8::NXCD, xcd = wgid % pg8::NXCD, off = wgid / pg8::NXCD; wgid = (xcd < r ? xcd * (q + 1) : r * (q + 1) + (xcd - r) * q) + off; }
        const int nig = pg8::WGM * nN, gid = wgid / nig, fm = gid * pg8::WGM, gsz = (nM - fm) < pg8::WGM ? (nM - fm) : pg8::WGM;
        u.pm = fm + ((wgid % nig) % gsz); u.pn = (wgid % nig) / gsz;
        u.a = A + (size_t)u.pm * 256 * K * 2; u.b = B + (size_t)u.pn * 256 * K * 2; u.e = 0; u.loc0 = 0; u.cnt = 0; u.pad = 0; return true;
    }
    __device__ __forceinline__ unsigned offA(const pg8::Unit&, int h, int R, int C) const { return (unsigned)((h * 128 + R) * K + C) * 2u; }
    __device__ __forceinline__ unsigned offB(int h, int R, int C) const {
        int row;
        if (bmode == 1) row = 64 * (R >> 5) + 32 * h + pg8::perm32(R & 31);
        else row = h * 128 + (perm ? ((R & ~31) + pg8::perm32(R & 31)) : R);
        return (unsigned)(row * K + C) * 2u;
    }
};

struct EpiQKV {
    bf16_t *Qd, *Kd, *Vd, *Qs, *Ks, *Vs; const float *gq, *gk;
    __device__ __forceinline__ void operator()(const f32x4 (&acc)[2][2][4][2], const pg8::Unit& u, int wr, int wc, int fr, int fq) const {
        asm volatile("" : "+v"(fr), "+v"(fq));
        const int pn = u.pn, sec = pn >> 1, G = 4 * (pn & 1) + wc;
        const int row0 = u.pm * 256 + wr * 64 + fr;
        const int b = row0 >> 13;
        float gv[2][2][4];
        if (sec < 2) { const float* g = sec == 0 ? gq : gk; const float sc = sec == 0 ? (0.125f * LOG2E) : 1.0f;
#pragma unroll
            for (int bj = 0; bj < 2; ++bj)
#pragma unroll
                for (int n = 0; n < 2; ++n) { const f32x4 t = *(const f32x4*)(g + 32 * bj + 8 * fq + 4 * n); gv[bj][n][0] = t[0] * sc; gv[bj][n][1] = t[1] * sc; gv[bj][n][2] = t[2] * sc; gv[bj][n][3] = t[3] * sc; }
        }
#pragma unroll
        for (int ai = 0; ai < 2; ++ai)
#pragma unroll
            for (int m = 0; m < 4; ++m) {
                const int row = row0 + ai * 128 + m * 16, s = row & (SEQ - 1);
                f32x4 v[2][2];
#pragma unroll
                for (int bj = 0; bj < 2; ++bj)
#pragma unroll
                    for (int n = 0; n < 2; ++n) v[bj][n] = acc[ai][bj][m][n];
                if (sec < 2) {
                    float ss = 0.f;
#pragma unroll
                    for (int bj = 0; bj < 2; ++bj)
#pragma unroll
                        for (int n = 0; n < 2; ++n) ss += (v[bj][n][0] * v[bj][n][0] + v[bj][n][1] * v[bj][n][1]) + (v[bj][n][2] * v[bj][n][2] + v[bj][n][3] * v[bj][n][3]);
                    ss += __shfl_xor(ss, 16); ss += __shfl_xor(ss, 32);
                    const float r = __builtin_amdgcn_rsqf(ss * (1.0f / 64.0f) + EPS);
#pragma unroll
                    for (int bj = 0; bj < 2; ++bj)
#pragma unroll
                        for (int n = 0; n < 2; ++n)
#pragma unroll
                            for (int i = 0; i < 4; ++i) v[bj][n][i] = v[bj][n][i] * r * gv[bj][n][i];
                } else if (sec == 3) {
#pragma unroll
                    for (int bj = 0; bj < 2; ++bj)
#pragma unroll
                        for (int n = 0; n < 2; ++n) v[bj][n] = v[bj][n] * (0.125f * LOG2E);
                }
#pragma unroll
                for (int bj = 0; bj < 2; ++bj) {
                    u32x4 w; w.x = cvtpk(v[bj][0][0], v[bj][0][1]); w.y = cvtpk(v[bj][0][2], v[bj][0][3]); w.z = cvtpk(v[bj][1][0], v[bj][1][1]); w.w = cvtpk(v[bj][1][2], v[bj][1][3]);
                    size_t off; bf16_t* base;
                    if (sec == 0 || sec == 3) {
                        base = sec == 0 ? Qd : Qs; off = ((size_t)(b * 8 + G) * SEQ + s) * 64 + 32 * bj + 8 * fq;
                    } else if (sec == 1 || sec == 4) {
                        base = sec == 1 ? Kd : Ks; off = ((((size_t)(b * 8 + G) * 128 + (s >> 6)) * 8 + 4 * bj + fq) * 64 + (s & 63)) * 8;
                    } else if (sec == 2) {
                        base = Vd; off = (((((size_t)(b * 4 + (G >> 1)) * 128 + (s >> 6)) * 4 + 2 * (G & 1) + bj) * 4 + ((s & 63) >> 4)) * 16 + (s & 15)) * 32 + 8 * fq;
                    } else {
                        base = Vs; off = (((((size_t)(b * 8 + G) * 128 + (s >> 6)) * 2 + bj) * 4 + ((s & 63) >> 4)) * 16 + (s & 15)) * 32 + 8 * fq;
                    }
                    *(u32x4*)(base + off) = w;
                }
            }
    }
};

struct EpiX1 {
    const float* x; float* out; const float* gt;
    __device__ __forceinline__ void operator()(const f32x4 (&acc)[2][2][4][2], const pg8::Unit& u, int wr, int wc, int fr, int fq) const {
        asm volatile("" : "+v"(fr), "+v"(fq));
        const int row0 = u.pm * 256 + wr * 64 + fr, b = row0 >> 13, col0 = u.pn * 256 + wc * 32 + 4 * fq;
        f32x4 g[2][2];
#pragma unroll
        for (int bj = 0; bj < 2; ++bj)
#pragma unroll
            for (int n = 0; n < 2; ++n) g[bj][n] = *(const f32x4*)(gt + (size_t)b * 6144 + col0 + bj * 128 + n * 16);
#pragma unroll
        for (int ai = 0; ai < 2; ++ai)
#pragma unroll
            for (int m = 0; m < 4; ++m) { const size_t off = (size_t)(row0 + ai * 128 + m * 16) * DM + col0;
#pragma unroll
                for (int bj = 0; bj < 2; ++bj)
#pragma unroll
                    for (int n = 0; n < 2; ++n) { const f32x4 xv = *(const f32x4*)(x + off + bj * 128 + n * 16); *(f32x4*)(out + off + bj * 128 + n * 16) = xv + g[bj][n] * acc[ai][bj][m][n]; } }
    }
};

struct MoeUpSched {
    static constexpr bool GATHER = true;
    int G, c; const LAS int* tpre; const LAS int* cnts; const int* list; const char* A; const char* B;
    __device__ __forceinline__ bool next(int i, pg8::Unit& u) const {
        const int L = i * G + c, T = tpre[32]; if (L >= 2 * T) return false;
        const int tau = L >> 1, pn = L & 1; int e = 0;
#pragma unroll 1
        for (int j = 1; j < 32; ++j) if (tpre[j] <= tau) e = j;
        u.pm = tau; u.pn = pn; u.e = e; u.loc0 = (tau - tpre[e]) * 256; u.cnt = cnts[e]; u.pad = 0;
        u.a = A; u.b = B + ((size_t)e * 512 + 128 * pn) * 1024 * 2; return true;
    }
    __device__ __forceinline__ unsigned offA(const pg8::Unit& u, int h, int R, int C) const {
        const int loc = u.loc0 + h * 128 + R; int tok = 0;
        if (loc < u.cnt) tok = list[u.e * MTOK + loc];
        return (unsigned)(tok * 1024 + C) * 2u;
    }
    __device__ __forceinline__ unsigned offB(int h, int R, int C) const { return (unsigned)((256 * h + (R & ~31) + pg8::perm32(R & 31)) * 1024 + C) * 2u; }
};
struct EpiAct {
    bf16_t* hg; const float* listw;
    __device__ __forceinline__ void operator()(const f32x4 (&acc)[2][2][4][2], const pg8::Unit& u, int wr, int wc, int fr, int fq) const {
        asm volatile("" : "+v"(fr), "+v"(fq));
        const int col0 = 128 * u.pn + 32 * wc + 8 * fq;
#pragma unroll
        for (int ai = 0; ai < 2; ++ai)
#pragma unroll
            for (int m = 0; m < 4; ++m) {
                const int rl = 128 * ai + 64 * wr + 16 * m + fr, loc = u.loc0 + rl;
                float w = 0.f; if (loc < u.cnt) w = listw[u.e * MTOK + loc];
                float o[8];
#pragma unroll
                for (int n = 0; n < 2; ++n)
#pragma unroll
                    for (int i = 0; i < 4; ++i) { const float a = acc[ai][0][m][n][i], g = acc[ai][1][m][n][i]; const float sg = a * __builtin_amdgcn_rcpf(1.0f + __builtin_amdgcn_exp2f(-a * LOG2E)); o[4 * n + i] = sg * g * w; }
                u32x4 q; q.x = cvtpk(o[0], o[1]); q.y = cvtpk(o[2], o[3]); q.z = cvtpk(o[4], o[5]); q.w = cvtpk(o[6], o[7]);
                *(u32x4*)(hg + ((size_t)u.pm * 256 + rl) * DEXP + col0) = q;
            }
    }
};
struct MoeDownSched {
    static constexpr bool GATHER = false;
    int G, c; const LAS int* tpre; const char* A; const char* B;
    __device__ __forceinline__ bool next(int i, pg8::Unit& u) const {
        const int L = i * G + c, T = tpre[32]; if (L >= 4 * T) return false;
        const int tau = L >> 2, pn = L & 3; int e = 0;
#pragma unroll 1
        for (int j = 1; j < 32; ++j) if (tpre[j] <= tau) e = j;
        u.pm = tau; u.pn = pn; u.e = e; u.loc0 = 0; u.cnt = 0; u.pad = 0;
        u.a = A + (size_t)tau * 256 * DEXP * 2; u.b = B + ((size_t)e * 1024 + 256 * pn) * DEXP * 2; return true;
    }
    __device__ __forceinline__ unsigned offA(const pg8::Unit&, int h, int R, int C) const { return (unsigned)((h * 128 + R) * DEXP + C) * 2u; }
    __device__ __forceinline__ unsigned offB(int h, int R, int C) const { return (unsigned)((h * 128 + (R & ~31) + pg8::perm32(R & 31)) * DEXP + C) * 2u; }
};
struct EpiY {
    bf16_t* y;
    __device__ __forceinline__ void operator()(const f32x4 (&acc)[2][2][4][2], const pg8::Unit& u, int wr, int wc, int fr, int fq) const {
        asm volatile("" : "+v"(fr), "+v"(fq));
        const int col0 = 256 * u.pn + 32 * wc + 8 * fq;
#pragma unroll
        for (int ai = 0; ai < 2; ++ai)
#pragma unroll
            for (int m = 0; m < 4; ++m) { bf16_t* rowp = y + ((size_t)u.pm * 256 + 128 * ai + 64 * wr + 16 * m + fr) * DM + col0;
#pragma unroll
                for (int bj = 0; bj < 2; ++bj) { const f32x4 v0 = acc[ai][bj][m][0], v1 = acc[ai][bj][m][1];
                    u32x4 w; w.x = cvtpk(v0[0], v0[1]); w.y = cvtpk(v0[2], v0[3]); w.z = cvtpk(v1[0], v1[1]); w.w = cvtpk(v1[2], v1[3]);
                    *(u32x4*)(rowp + bj * 128) = w; } }
    }
};

namespace att {
__device__ __forceinline__ int crow(int r, int hi) { return (r & 3) + 8 * (r >> 2) + 4 * hi; }
__device__ __forceinline__ s16x4 vtr(const LAS unsigned char* p) { return __builtin_bit_cast(s16x4, __builtin_amdgcn_ds_read_tr16_b64_v4i16((LAS s16x4*)p)); }
__device__ __forceinline__ bf16x8 cat8(s16x4 lo, s16x4 hi) { return (bf16x8){lo[0], lo[1], lo[2], lo[3], hi[0], hi[1], hi[2], hi[3]}; }
__device__ __forceinline__ float swap_add(float v) { auto rr = __builtin_amdgcn_permlane32_swap(__float_as_uint(v), __float_as_uint(v), false, false); return __uint_as_float(rr[0]) + __uint_as_float(rr[1]); }

struct AttnP {
    const bf16_t *Qd, *Kd, *Vd, *Qs, *Ks, *Vs; bf16_t* AO;
    const float *gq, *gk, *lq1, *lk1, *lq2, *lk2, *dog, *sog;
};

__device__ __forceinline__ void diff_unit(const AttnP& P, int b, int hh, int iq, LAS unsigned char* lds, float lam, float Mp) {
    const int tid = threadIdx.x, lane = tid & 63, r32 = lane & 31, hi = lane >> 5;
    const int wid = __builtin_amdgcn_readfirstlane(tid >> 6), mp = wid >> 2, rg = wid & 3;
    const int q0 = iq * 128, qw0 = q0 + 32 * rg, NT = 2 * (iq + 1);
    const int vh = 2 * hh + mp;
    const float slope = exp2f(-2.0f * (float)(hh + 1)) * LOG2E;
    const bf16_t* Qg = P.Qd + ((size_t)(b * 8 + vh) * SEQ + qw0 + r32) * 64;
    const unsigned char* K0g = (const unsigned char*)(P.Kd + (size_t)(b * 8 + 2 * hh) * SEQ * 64);
    const unsigned char* K1g = (const unsigned char*)(P.Kd + (size_t)(b * 8 + 2 * hh + 1) * SEQ * 64);
    const unsigned char* Vg = (const unsigned char*)(P.Vd + (size_t)(b * 4 + hh) * SEQ * 128);
    bf16x8 qf[4];
#pragma unroll
    for (int s = 0; s < 4; ++s) qf[s] = *(const bf16x8*)(Qg + 16 * s + 8 * hi);
    const float lbase = slope * (float)(4 * hi - r32);
    f32x16 o[4];
#pragma unroll
    for (int d = 0; d < 4; ++d) o[d] = f32x16{};
    float lsum = 0.f;
    const unsigned ldsw = (unsigned)wid * 1024u;
#define GLDS16(src, dstoff) __builtin_amdgcn_global_load_lds((const unsigned*)(src), (LAS unsigned*)(lds + (dstoff) + ldsw), 16, 0, 0)
#define DLOAD(j, buf) do { GLDS16(K0g + (size_t)(j) * 8192 + tid * 16, (buf) * 32768); GLDS16(K1g + (size_t)(j) * 8192 + tid * 16, (buf) * 32768 + 8192); \
        GLDS16(Vg + (size_t)(j) * 16384 + tid * 16, (buf) * 32768 + 16384); GLDS16(Vg + (size_t)(j) * 16384 + 8192 + tid * 16, (buf) * 32768 + 24576); } while (0)
    DLOAD(0, 0); VM_WAIT(); __syncthreads();
    const int vlane = ((lane >> 4) & 1) * 32 + (lane & 3) * 8 + (4 * hi + ((lane & 15) >> 2)) * 64;
    for (int j = 0; j < NT; ++j) {
        const int buf = j & 1;
        if (j + 1 < NT) DLOAD(j + 1, buf ^ 1);
        if (64 * j <= qw0 + 31) {
            const LAS unsigned char* Kb = lds + buf * 32768 + mp * 8192 + hi * 1024 + r32 * 16;
            const LAS unsigned char* Vb = lds + buf * 32768 + 16384 + vlane;
            const float T0 = -Mp - slope * (float)(qw0 - 64 * j), T1 = T0 + 32.0f * slope;
            f32x16 p0, p1;
#pragma unroll
            for (int r = 0; r < 16; ++r) { const float cr = (float)((r & 3) + 8 * (r >> 2)); p0[r] = fmaf(slope, cr, T0 + lbase); p1[r] = fmaf(slope, cr, T1 + lbase); }
#pragma unroll
            for (int s = 0; s < 4; ++s) {
                const bf16x8 a0 = *(const LAS bf16x8*)(Kb + s * 2048), a1 = *(const LAS bf16x8*)(Kb + s * 2048 + 512);
                p0 = __builtin_amdgcn_mfma_f32_32x32x16_bf16(a0, qf[s], p0, 0, 0, 0);
                p1 = __builtin_amdgcn_mfma_f32_32x32x16_bf16(a1, qf[s], p1, 0, 0, 0);
            }
            if (64 * j + 63 > qw0) {
                const int dq = qw0 + r32 - 64 * j;
#pragma unroll
                for (int r = 0; r < 16; ++r) { const int k0 = crow(r, hi); if (k0 > dq) p0[r] = -1e30f; if (k0 + 32 > dq) p1[r] = -1e30f; }
            }
#pragma unroll
            for (int r = 0; r < 16; ++r) { p0[r] = __builtin_amdgcn_exp2f(p0[r]); p1[r] = __builtin_amdgcn_exp2f(p1[r]); }
            float sa = 0.f, sb = 0.f;
#pragma unroll
            for (int r = 0; r < 16; ++r) { sa += p0[r]; sb += p1[r]; }
            lsum += sa + sb;
            bf16x8 pf[4];
#pragma unroll
            for (int g = 0; g < 4; ++g) {
                u32x4 w;
                if (g < 2) { w.x = cvtpk(p0[8 * g + 0], p0[8 * g + 1]); w.y = cvtpk(p0[8 * g + 2], p0[8 * g + 3]); w.z = cvtpk(p0[8 * g + 4], p0[8 * g + 5]); w.w = cvtpk(p0[8 * g + 6], p0[8 * g + 7]); }
                else { const int q = g - 2; w.x = cvtpk(p1[8 * q + 0], p1[8 * q + 1]); w.y = cvtpk(p1[8 * q + 2], p1[8 * q + 3]); w.z = cvtpk(p1[8 * q + 4], p1[8 * q + 5]); w.w = cvtpk(p1[8 * q + 6], p1[8 * q + 7]); }
                pf[g] = __builtin_bit_cast(bf16x8, w);
            }
#pragma unroll
            for (int d = 0; d < 4; ++d)
#pragma unroll
                for (int g = 0; g < 4; ++g) {
                    const bf16x8 vf = cat8(vtr(Vb + d * 4096 + g * 1024), vtr(Vb + d * 4096 + g * 1024 + 512));
                    o[d] = __builtin_amdgcn_mfma_f32_32x32x16_bf16(vf, pf[g], o[d], 0, 0, 0);
                }
        }
        VM_WAIT(); __syncthreads();
    }
#undef DLOAD
    lsum = swap_add(lsum);
    const float inv = 1.0f / lsum;
    LAS float* exch = (LAS float*)lds + rg * 4096;
    if (mp == 1) {
#pragma unroll
        for (int d = 0; d < 4; ++d)
#pragma unroll
            for (int r = 0; r < 16; ++r) exch[(32 * d + crow(r, hi)) * 32 + r32] = o[d][r] * inv;
    }
    __syncthreads();
    if (mp == 0) {
        float ss = 0.f;
#pragma unroll
        for (int d = 0; d < 4; ++d)
#pragma unroll
            for (int r = 0; r < 16; ++r) { const float v = o[d][r] * inv - lam * exch[(32 * d + crow(r, hi)) * 32 + r32]; o[d][r] = v; ss += v * v; }
        ss = swap_add(ss);
        const float rr = __builtin_amdgcn_rsqf(ss * (1.0f / 128.0f) + EPS) * (1.0f - LAMBDA_INIT);
        LAS unsigned char* stg = lds + 65536 + rg * 8704;
#pragma unroll
        for (int d = 0; d < 4; ++d)
#pragma unroll
            for (int r = 0; r < 16; r += 2) { const int dd = 32 * d + crow(r, hi);
                *(LAS unsigned*)(stg + r32 * 272 + dd * 2) = cvtpk(o[d][r] * rr * P.dog[dd], o[d][r + 1] * rr * P.dog[dd + 1]); }
        LDS_WAIT();
        bf16_t* Og = P.AO + ((size_t)(b * SEQ) + qw0) * DM + 128 * hh;
#pragma unroll
        for (int it = 0; it < 8; ++it) { const int idx = it * 64 + lane, row = idx >> 4, ch = idx & 15;
            const u32x4 v = *(const LAS u32x4*)(stg + row * 272 + ch * 16); *(u32x4*)(Og + (size_t)row * DM + ch * 8) = v; }
    }
    __syncthreads();
}

__device__ __forceinline__ void sb_unit(const AttnP& P, int b, int h, int qb, LAS unsigned char* lds) {
    const int tid = threadIdx.x, lane = tid & 63, r32 = lane & 31, hi = lane >> 5;
    const int wid = __builtin_amdgcn_readfirstlane(tid >> 6);
    const int q0 = qb * 256, qw0 = q0 + 32 * wid, NT = 4 * (qb + 1);
    const bf16_t* Qg = P.Qs + ((size_t)(b * 8 + h) * SEQ + qw0 + r32) * 64;
    const unsigned char* Kg = (const unsigned char*)(P.Ks + (size_t)(b * 8 + h) * SEQ * 64);
    const unsigned char* Vg = (const unsigned char*)(P.Vs + (size_t)(b * 8 + h) * SEQ * 64);
    bf16x8 qf[4];
#pragma unroll
    for (int s = 0; s < 4; ++s) qf[s] = *(const bf16x8*)(Qg + 16 * s + 8 * hi);
    f16x8 atri[2], aone;
#pragma unroll
    for (int st = 0; st < 2; ++st)
#pragma unroll
        for (int jj = 0; jj < 8; ++jj) { const int j = 16 * st + 8 * (jj >> 2) + 4 * hi + (jj & 3); atri[st][jj] = (j >= r32) ? (_Float16)(-1.0f) : (_Float16)0.0f; }
#pragma unroll
    for (int jj = 0; jj < 8; ++jj) aone[jj] = (_Float16)(-1.0f);
    f32x16 o[2]; o[0] = f32x16{}; o[1] = f32x16{};
    f32x16 carry = f32x16{};
    const unsigned ldsw = (unsigned)wid * 1024u;
#define SLOAD(j, buf) do { GLDS16(Kg + (size_t)(j) * 8192 + tid * 16, (buf) * 16384); GLDS16(Vg + (size_t)(j) * 8192 + tid * 16, (buf) * 16384 + 8192); } while (0)
    SLOAD(NT - 1, 0); VM_WAIT(); __syncthreads();
    const int vlane = ((lane >> 4) & 1) * 32 + (lane & 3) * 8 + (4 * hi + ((lane & 15) >> 2)) * 64;
    int buf = 0;
    for (int j = NT - 1; j >= 0; --j) {
        if (j > 0) SLOAD(j - 1, buf ^ 1);
        if (64 * j <= qw0 + 31) {
            const LAS unsigned char* Kb = lds + buf * 16384 + hi * 1024 + r32 * 16;
            const LAS unsigned char* Vb = lds + buf * 16384 + 8192 + vlane;
            f32x16 z0 = f32x16{}, z1 = f32x16{};
#pragma unroll
            for (int s = 0; s < 4; ++s) {
                const bf16x8 a0 = *(const LAS bf16x8*)(Kb + s * 2048), a1 = *(const LAS bf16x8*)(Kb + s * 2048 + 512);
                z0 = __builtin_amdgcn_mfma_f32_32x32x16_bf16(a0, qf[s], z0, 0, 0, 0);
                z1 = __builtin_amdgcn_mfma_f32_32x32x16_bf16(a1, qf[s], z1, 0, 0, 0);
            }
            const bool diag = (64 * j + 63 >= qw0);
            const int dq = qw0 + r32 - 64 * j;
#define SBLK(Z, BLK) do { \
            f32x16 w_; \
            _Pragma("unroll") for (int r = 0; r < 16; ++r) { const float u_ = __builtin_amdgcn_exp2f(Z[r]); w_[r] = __builtin_amdgcn_logf(1.0f + u_); } \
            if (diag) { _Pragma("unroll") for (int r = 0; r < 16; ++r) if (crow(r, hi) + 32 * (BLK) >= dq) w_[r] = 0.f; } \
            f16x8 x0_, x1_; \
            _Pragma("unroll") for (int q = 0; q < 4; ++q) { const f16x2 t0_ = __builtin_bit_cast(f16x2, __builtin_amdgcn_cvt_pkrtz(w_[2 * q], w_[2 * q + 1])); x0_[2 * q] = t0_[0]; x0_[2 * q + 1] = t0_[1]; \
                const f16x2 t1_ = __builtin_bit_cast(f16x2, __builtin_amdgcn_cvt_pkrtz(w_[8 + 2 * q], w_[8 + 2 * q + 1])); x1_[2 * q] = t1_[0]; x1_[2 * q + 1] = t1_[1]; } \
            f32x16 inc_ = __builtin_amdgcn_mfma_f32_32x32x16_f16(atri[0], x0_, carry, 0, 0, 0); \
            inc_ = __builtin_amdgcn_mfma_f32_32x32x16_f16(atri[1], x1_, inc_, 0, 0, 0); \
            carry = __builtin_amdgcn_mfma_f32_32x32x16_f16(aone, x0_, carry, 0, 0, 0); \
            carry = __builtin_amdgcn_mfma_f32_32x32x16_f16(aone, x1_, carry, 0, 0, 0); \
            _Pragma("unroll") for (int r = 0; r < 16; ++r) w_[r] = __builtin_amdgcn_exp2f(Z[r] + inc_[r]); \
            if (diag) { _Pragma("unroll") for (int r = 0; r < 16; ++r) if (crow(r, hi) + 32 * (BLK) >= dq) w_[r] = 0.f; } \
            _Pragma("unroll") for (int sp = 0; sp < 2; ++sp) { \
                u32x4 pw_; pw_.x = cvtpk(w_[8 * sp + 0], w_[8 * sp + 1]); pw_.y = cvtpk(w_[8 * sp + 2], w_[8 * sp + 3]); pw_.z = cvtpk(w_[8 * sp + 4], w_[8 * sp + 5]); pw_.w = cvtpk(w_[8 * sp + 6], w_[8 * sp + 7]); \
                const bf16x8 pf_ = __builtin_bit_cast(bf16x8, pw_); const int g_ = 2 * (BLK) + sp; \
                _Pragma("unroll") for (int d = 0; d < 2; ++d) { const bf16x8 vf_ = cat8(vtr(Vb + d * 4096 + g_ * 1024), vtr(Vb + d * 4096 + g_ * 1024 + 512)); \
                    o[d] = __builtin_amdgcn_mfma_f32_32x32x16_bf16(vf_, pf_, o[d], 0, 0, 0); } } \
            } while (0)
            SBLK(z1, 1);
            SBLK(z0, 0);
#undef SBLK
        }
        VM_WAIT(); __syncthreads();
        buf ^= 1;
    }
#undef SLOAD
#undef GLDS16
    float ss = 0.f;
#pragma unroll
    for (int d = 0; d < 2; ++d)
#pragma unroll
        for (int r = 0; r < 16; ++r) ss += o[d][r] * o[d][r];
    ss = swap_add(ss);
    const float rr = __builtin_amdgcn_rsqf(ss * (1.0f / 64.0f) + EPS);
    LAS unsigned char* stg = lds + 32768 + wid * 4608;
#pragma unroll
    for (int d = 0; d < 2; ++d)
#pragma unroll
        for (int r = 0; r < 16; r += 2) { const int dd = 32 * d + crow(r, hi);
            *(LAS unsigned*)(stg + r32 * 144 + dd * 2) = cvtpk(o[d][r] * rr * P.sog[dd], o[d][r + 1] * rr * P.sog[dd + 1]); }
    LDS_WAIT();
    bf16_t* Og = P.AO + ((size_t)(b * SEQ) + qw0) * DM + 512 + 64 * h;
#pragma unroll
    for (int it = 0; it < 4; ++it) { const int idx = it * 64 + lane, row = idx >> 3, ch = idx & 7;
        const u32x4 v = *(const LAS u32x4*)(stg + row * 144 + ch * 16); *(u32x4*)(Og + (size_t)row * DM + ch * 8) = v; }
    __syncthreads();
}
}

#ifndef MK_N_LAUNCHES
#define MK_N_LAUNCHES 1
#endif
constexpr int N_PHASES = 9;
struct Args { const float* in[23]; float* out; unsigned char* ws; int ph_lo, ph_hi; };

__device__ __forceinline__ void p0_transpose_item(const float* W, int K, int N, bf16_t* WT, int row_off, LAS float* scr, int item, int lane) {
    const int nblk = N / 32, kb = item / nblk, nb = item % nblk, k0 = 64 * kb, n0 = 32 * nb;
#pragma unroll 8
    for (int i = 0; i < 32; ++i) { const int kk = 2 * i + (lane >> 5); scr[kk * 33 + (lane & 31)] = W[(size_t)(k0 + kk) * N + n0 + (lane & 31)]; }
    LDS_WAIT(); asm volatile("" ::: "memory");
    const int c = lane & 7;
#pragma unroll
    for (int j = 0; j < 4; ++j) { const int n = (lane >> 3) + 8 * j; const LAS float* s = scr + (8 * c) * 33 + n;
        u32x4 o; o.x = pk2(s[0 * 33], s[1 * 33]); o.y = pk2(s[2 * 33], s[3 * 33]); o.z = pk2(s[4 * 33], s[5 * 33]); o.w = pk2(s[6 * 33], s[7 * 33]);
        *(u32x4*)(WT + (size_t)(row_off + n0 + n) * K + k0 + 8 * c) = o; }
    LDS_WAIT(); asm volatile("" ::: "memory");
}

__global__ void __launch_bounds__(NWAVES * 64, 2) mega_fwd(Args args) {
    extern __shared__ __attribute__((aligned(16))) unsigned char lds_raw[];
    LAS unsigned char* lds = (LAS unsigned char*)lds_raw;
    volatile LAS unsigned* MISC = (volatile LAS unsigned*)(lds + MISC_OFF);
    const int tid = threadIdx.x, lane = tid & 63, wave = __builtin_amdgcn_readfirstlane(tid >> 6);
    const int G = gridDim.x; const int bx = blockIdx.x;
    const int vcu = (G % 8 == 0) ? (bx % 8) * (G / 8) + bx / 8 : bx;
    unsigned char* ws = args.ws;
    unsigned* ctl = (unsigned*)(ws + WS_CTL);
    float* modv = (float*)(ws + WS_MODV);
    bf16_t* Wr_t = (bf16_t*)(ws + WS_WR); bf16_t* Win_t = (bf16_t*)(ws + WS_WIN); bf16_t* Wout_t = (bf16_t*)(ws + WS_WOUT);
    bf16_t* W13_t = (bf16_t*)(ws + WS_W13); bf16_t* W2_t = (bf16_t*)(ws + WS_W2); bf16_t* HB = (bf16_t*)(ws + WS_HB);
    bf16_t* AO = (bf16_t*)(ws + WS_AO); bf16_t* HG = (bf16_t*)(ws + WS_HG); bf16_t* Y = (bf16_t*)(ws + WS_Y);
    int* tokinfo = (int*)(ws + WS_ROUTE); int* list = (int*)(ws + WS_LIST); float* listw = (float*)(ws + WS_LISTW);
    const float* x = args.in[0]; float* out = args.out;

    for (int u = tid; u < (LDS_BYTES - LDSCTL_OFF) / 4; u += NWAVES * 64) ((LAS unsigned*)(lds + LDSCTL_OFF))[u] = 0u;
    __syncthreads();
    XcdBarrier bar; bar.bar = ctl + CW_BAR; bar.x = 0; bar.st = nullptr;
    if (MK_N_LAUNCHES == 1) bar = xcd_barrier_post(ctl + CW_BAR, MISC + 8);
#define GRID_BAR() do { if (MK_N_LAUNCHES == 1) xcd_barrier(bar); } while (0)
    const int lo = args.ph_lo, hi = args.ph_hi;
#ifndef PHMASK
#define PHMASK 0x1ff
#endif
#define IN(k) ((((PHMASK) >> (k)) & 1) && lo <= (k) && (k) < hi)
#define BOTH(k) (IN(k) && IN((k) + 1))
    const int gw = vcu * NWAVES + wave, NGW = G * NWAVES;

    if (IN(0)) {
        for (int item = vcu; item < 192; item += G) {
            LAS float* sl = (LAS float*)lds;
            LAS float* red = (LAS float*)(lds + 8192);
            for (int i = tid; i < 2048; i += 512) { const float c = args.in[1][i]; sl[i] = c / (1.0f + __expf(-c)); }
            __syncthreads();
            const int n0 = 32 * item, col = lane & 31, kh = lane >> 5;
            const float* W = args.in[2] + n0 + col;
            float a0 = 0.f, a1 = 0.f;
#pragma unroll 16
            for (int i = 0; i < 64; ++i) { const int k = 128 * wave + 2 * i + kh; const float w = W[(size_t)k * 6144]; a0 += sl[k] * w; a1 += sl[1024 + k] * w; }
            a0 += __shfl_xor(a0, 32); a1 += __shfl_xor(a1, 32);
            if (lane < 32) { red[(wave * 2 + 0) * 32 + col] = a0; red[(wave * 2 + 1) * 32 + col] = a1; }
            __syncthreads();
            if (tid < 64) { const int b = tid >> 5, c2 = tid & 31; float v = 0.f;
#pragma unroll
                for (int w = 0; w < 8; ++w) v += red[(w * 2 + b) * 32 + c2];
                const int n = n0 + c2, j = n >> 10, k = n & 1023; v += args.in[3][n];
                if (j == 1) v = args.in[4][k] * (1.0f + v);
                if (j == 4) v = args.in[15][k] * (1.0f + v);
                modv[(b * 6 + j) * 1024 + k] = v; }
            __syncthreads();
        }
        if (vcu == G - 1) {
            for (int idx = tid; idx < 65536; idx += 512) { const int j = idx >> 10, k = idx & 1023; float v = 0.f;
                if (j < 4) v = args.in[16][k * 4 + j]; else if (j < 36) v = args.in[18][(size_t)((j - 4) >> 3) * 8192 + k * 8 + ((j - 4) & 7)];
                Wr_t[idx] = (bf16_t)f2bf(v); }
        }
        LAS float* scr = (LAS float*)(lds + wave * 16384);
        constexpr int I_IN = 16 * 96, I_OUT = 16 * 32, I_E = 128, NITEMS = I_IN + I_OUT + 3 * 32 * I_E;
        for (int it = gw; it < NITEMS; it += NGW) {
            int r = it;
            if (r < I_IN) { p0_transpose_item(args.in[5], 1024, 3072, Win_t, 0, scr, r, lane); continue; } r -= I_IN;
            if (r < I_OUT) { p0_transpose_item(args.in[14], 1024, 1024, Wout_t, 0, scr, r, lane); continue; } r -= I_OUT;
            if (r < 32 * I_E) { const int e = r / I_E; p0_transpose_item(args.in[20] + (size_t)e * 1024 * 256, 1024, 256, W13_t + (size_t)e * 512 * 1024, 0, scr, r % I_E, lane); continue; } r -= 32 * I_E;
            if (r < 32 * I_E) { const int e = r / I_E; p0_transpose_item(args.in[21] + (size_t)e * 1024 * 256, 1024, 256, W13_t + (size_t)e * 512 * 1024, 256, scr, r % I_E, lane); continue; } r -= 32 * I_E;
            { const int e = r / I_E; p0_transpose_item(args.in[22] + (size_t)e * 256 * 1024, 256, 1024, W2_t + (size_t)e * 1024 * 256, 0, scr, r % I_E, lane); }
        }
        if (BOTH(0)) GRID_BAR();
    }

    if (IN(1)) {
        for (int m = gw; m < MTOK; m += NGW) {
            const int b = m >> 13;
            const f32x4* xr = (const f32x4*)(x + (size_t)m * DM) + lane;
            const f32x4* gm = (const f32x4*)(modv + (b * 6 + 1) * 1024) + lane; const f32x4* sh = (const f32x4*)(modv + (b * 6 + 0) * 1024) + lane;
            f32x4 v[4]; float s = 0.f;
#pragma unroll
            for (int j = 0; j < 4; ++j) { v[j] = xr[64 * j]; s += (v[j].x * v[j].x + v[j].y * v[j].y) + (v[j].z * v[j].z + v[j].w * v[j].w); }
            const float rstd = __builtin_amdgcn_rsqf(wave_sum(s) * (1.f / DM) + EPS);
            unsigned long long* o8 = (unsigned long long*)(HB + (size_t)m * DM) + lane;
#pragma unroll
            for (int j = 0; j < 4; ++j) { const f32x4 g = gm[64 * j], t = sh[64 * j]; const f32x4 hq = v[j] * rstd * g + t;
                o8[64 * j] = (unsigned long long)cvtpk(hq.x, hq.y) | ((unsigned long long)cvtpk(hq.z, hq.w) << 32); }
        }
        if (BOTH(1)) GRID_BAR();
    }

    if (IN(2)) {
        DenseSched S; S.nM = MTOK / 256; S.nN = INC / 256; S.nwg = S.nM * S.nN; S.G = G; S.c = bx; S.K = DM; S.A = (const char*)HB; S.B = (const char*)Win_t; S.bmode = 1; S.perm = true;
        EpiQKV E{(bf16_t*)(ws + WS_QD), (bf16_t*)(ws + WS_KD), (bf16_t*)(ws + WS_VD), (bf16_t*)(ws + WS_QS), (bf16_t*)(ws + WS_KS), (bf16_t*)(ws + WS_VS), args.in[6], args.in[7]};
        pg8::gemm_phase<EpiQKV, DenseSched, true>(lds + RING_OFF, DM, S, E);
        if (BOTH(2)) GRID_BAR();
    }

    if (IN(3)) {
        att::AttnP P{(const bf16_t*)(ws + WS_QD), (const bf16_t*)(ws + WS_KD), (const bf16_t*)(ws + WS_VD), (const bf16_t*)(ws + WS_QS), (const bf16_t*)(ws + WS_KS), (const bf16_t*)(ws + WS_VS), AO,
                     args.in[6], args.in[7], args.in[8], args.in[9], args.in[10], args.in[11], args.in[12], args.in[13]};
        const float e1 = wave_sum(P.lq1[lane] * P.lk1[lane]), e2 = wave_sum(P.lq2[lane] * P.lk2[lane]);
        const float lam = __expf(e1) - __expf(e2) + LAMBDA_INIT;
        const float Mp = 8.0f * wave_max(fabsf(P.gq[lane])) * wave_max(fabsf(P.gk[lane])) * LOG2E;
        const int v = (G == 256) ? vcu : -1;
        if (v >= 0) {
            { const int bh = v >> 4, s = v & 15; att::sb_unit(P, bh >> 3, bh & 7, 31 - s, lds); att::sb_unit(P, bh >> 3, bh & 7, s, lds); }
            { const int bh = v >> 5, s = v & 31; att::diff_unit(P, bh >> 2, bh & 3, 63 - s, lds, lam, Mp); att::diff_unit(P, bh >> 2, bh & 3, s, lds, lam, Mp); }
        } else {
            for (int u = bx; u < 512; u += G) { const int bh = u >> 5, qb = u & 31; att::sb_unit(P, bh >> 3, bh & 7, qb, lds); }
            for (int u = bx; u < 512; u += G) { const int bh = u >> 6, iq = u & 63; att::diff_unit(P, bh >> 2, bh & 3, iq, lds, lam, Mp); }
        }
        if (BOTH(3)) GRID_BAR();
    }

    if (IN(4)) {
        DenseSched S; S.nM = MTOK / 256; S.nN = DM / 256; S.nwg = S.nM * S.nN; S.G = G; S.c = bx; S.K = DM; S.A = (const char*)AO; S.B = (const char*)Wout_t; S.bmode = 0; S.perm = false;
        EpiX1 E{x, out, modv + 2 * 1024};
        pg8::gemm_phase<EpiX1, DenseSched, false>(lds + RING_OFF, DM, S, E);
        if (BOTH(4)) GRID_BAR();
    }

    if (IN(5)) {
        LAS unsigned char* At = lds;
        LAS float* red = (LAS float*)(lds + 66560);
        for (int T = vcu; T < MTOK / 32; T += G) {
            const int row0 = T * 32, b = row0 >> 13;
#pragma unroll 1
            for (int rr = 0; rr < 4; ++rr) {
                const int rl = 4 * wave + rr, m = row0 + rl;
                const f32x4* xr = (const f32x4*)(out + (size_t)m * DM) + lane;
                const f32x4* gm = (const f32x4*)(modv + (b * 6 + 4) * 1024) + lane; const f32x4* sh = (const f32x4*)(modv + (b * 6 + 3) * 1024) + lane;
                f32x4 v[4]; float s = 0.f;
#pragma unroll
                for (int j = 0; j < 4; ++j) { v[j] = xr[64 * j]; s += (v[j].x * v[j].x + v[j].y * v[j].y) + (v[j].z * v[j].z + v[j].w * v[j].w); }
                const float rstd = __builtin_amdgcn_rsqf(wave_sum(s) * (1.f / DM) + EPS);
                unsigned long long* o8 = (unsigned long long*)(HB + (size_t)m * DM) + lane;
#pragma unroll
                for (int j = 0; j < 4; ++j) { const f32x4 g = gm[64 * j], t = sh[64 * j]; const f32x4 hq = v[j] * rstd * g + t;
                    const unsigned long long pk = (unsigned long long)cvtpk(hq.x, hq.y) | ((unsigned long long)cvtpk(hq.z, hq.w) << 32);
                    o8[64 * j] = pk; *(LAS unsigned long long*)(At + rl * 2064 + (4 * lane + 256 * j) * 2) = pk; }
            }
            __syncthreads();
            {
                f32x4 acc[2][3];
#pragma unroll
                for (int mf = 0; mf < 2; ++mf)
#pragma unroll
                    for (int nf = 0; nf < 3; ++nf) acc[mf][nf] = (f32x4){0.f, 0.f, 0.f, 0.f};
                const int fr = lane & 15, fq = lane >> 4;
#pragma unroll
                for (int ks = 0; ks < 4; ++ks) {
                    const int k0 = 128 * wave + 32 * ks + 8 * fq;
                    bf16x8 af[2], bfm[3];
#pragma unroll
                    for (int mf = 0; mf < 2; ++mf) af[mf] = *(const LAS bf16x8*)(At + (16 * mf + fr) * 2064 + k0 * 2);
#pragma unroll
                    for (int nf = 0; nf < 3; ++nf) bfm[nf] = *(const bf16x8*)(Wr_t + (size_t)(16 * nf + fr) * 1024 + k0);
#pragma unroll
                    for (int mf = 0; mf < 2; ++mf)
#pragma unroll
                        for (int nf = 0; nf < 3; ++nf) acc[mf][nf] = __builtin_amdgcn_mfma_f32_16x16x32_bf16(af[mf], bfm[nf], acc[mf][nf], 0, 0, 0);
                }
#pragma unroll
                for (int mf = 0; mf < 2; ++mf)
#pragma unroll
                    for (int nf = 0; nf < 3; ++nf)
#pragma unroll
                        for (int i = 0; i < 4; ++i) red[(wave * 32 + 16 * mf + 4 * fq + i) * 48 + 16 * nf + fr] = acc[mf][nf][i];
            }
            __syncthreads();
            if (tid < 32) {
                const int m = row0 + tid;
                float gl[4];
#pragma unroll
                for (int c = 0; c < 4; ++c) { float v = args.in[17][c];
#pragma unroll
                    for (int w = 0; w < 8; ++w) v += red[(w * 32 + tid) * 48 + c]; gl[c] = v; }
                int gs = 0; float gmax = gl[0];
#pragma unroll
                for (int c = 1; c < 4; ++c) if (gl[c] > gmax) { gmax = gl[c]; gs = c; }
                float den = 0.f;
#pragma unroll
                for (int c = 0; c < 4; ++c) den += __expf(gl[c] - gmax);
                const float gate = 1.0f / den;
                float el[8];
#pragma unroll
                for (int e = 0; e < 8; ++e) { float v = args.in[19][gs * 8 + e];
#pragma unroll
                    for (int w = 0; w < 8; ++w) v += red[(w * 32 + tid) * 48 + 4 + gs * 8 + e]; el[e] = v; }
                int e0 = 0; float t0 = el[0];
#pragma unroll
                for (int e = 1; e < 8; ++e) if (el[e] > t0) { t0 = el[e]; e0 = e; }
                int e1 = -1; float t1 = -INFINITY;
#pragma unroll
                for (int e = 0; e < 8; ++e) if (e != e0 && el[e] > t1) { t1 = el[e]; e1 = e; }
                const float w0 = 1.0f / (1.0f + __expf(t1 - t0)), w1 = 1.0f - w0;
                const int ge0 = gs * 8 + e0, ge1 = gs * 8 + e1;
                const int p0 = (int)atomicAdd(ctl + CW_CNT + ge0, 1u), p1 = (int)atomicAdd(ctl + CW_CNT + ge1, 1u);
                list[ge0 * MTOK + p0] = m; listw[ge0 * MTOK + p0] = gate * w0;
                list[ge1 * MTOK + p1] = m; listw[ge1 * MTOK + p1] = gate * w1;
                *(int4*)(tokinfo + 4 * m) = make_int4(ge0, p0, ge1, p1);
            }
            __syncthreads();
        }
        if (BOTH(5)) GRID_BAR();
    }

    LAS int* tpre = (LAS int*)(lds + TPRE_OFF); LAS int* cnts = tpre + 64;
    if (IN(6) || IN(7) || IN(8)) {
        if (tid == 0) { int acc = 0; for (int e = 0; e < 32; ++e) { const int c = (int)__hip_atomic_load(ctl + CW_CNT + e, RLX_AGENT); cnts[e] = c; tpre[e] = acc; acc += (c + 255) >> 8; } tpre[32] = acc; }
        __syncthreads();
    }
    if (IN(6)) {
        MoeUpSched S{G, bx, tpre, cnts, list, (const char*)HB, (const char*)W13_t};
        EpiAct E{HG, listw};
        pg8::gemm_phase<EpiAct, MoeUpSched, false>(lds + RING_OFF, DM, S, E);
        if (BOTH(6)) GRID_BAR();
    }
    if (IN(7)) {
        MoeDownSched S{G, bx, tpre, (const char*)HG, (const char*)W2_t};
        EpiY E{Y};
        pg8::gemm_phase<EpiY, MoeDownSched, false>(lds + RING_OFF, DEXP, S, E);
        if (BOTH(7)) GRID_BAR();
    }
    if (IN(8)) {
        int tb = 0; if (lane < 32) tb = tpre[lane] * 256;
        for (int m = gw; m < MTOK; m += NGW) {
            const int b = m >> 13; const int4 inf = *(const int4*)(tokinfo + 4 * m);
            const int s0 = __shfl(tb, inf.x) + inf.y, s1 = __shfl(tb, inf.z) + inf.w;
            f32x4* orow = (f32x4*)(out + (size_t)m * DM) + lane; const f32x4* gt = (const f32x4*)(modv + (b * 6 + 5) * 1024) + lane;
            const u32x2* y0 = (const u32x2*)(Y + (size_t)s0 * DM) + lane; const u32x2* y1 = (const u32x2*)(Y + (size_t)s1 * DM) + lane;
#pragma unroll
            for (int j = 0; j < 4; ++j) { const u32x2 a = y0[64 * j], c = y1[64 * j]; const f32x4 g = gt[64 * j]; f32x4 xv = orow[64 * j];
                f32x4 ys; ys.x = __uint_as_float(a.x << 16) + __uint_as_float(c.x << 16); ys.y = __uint_as_float(a.x & 0xffff0000u) + __uint_as_float(c.x & 0xffff0000u);
                ys.z = __uint_as_float(a.y << 16) + __uint_as_float(c.y << 16); ys.w = __uint_as_float(a.y & 0xffff0000u) + __uint_as_float(c.y & 0xffff0000u);
                orow[64 * j] = xv + g * ys; }
        }
    }
#undef IN
#undef BOTH
#undef GRID_BAR
}

extern "C" void kernel_launch(void* const* d_in, const int* in_sizes, int n_in, void* d_out, int out_size, void* d_ws, size_t ws_size, hipStream_t stream) {
    static int grid = 0;
    if (grid == 0) {
        if (n_in != 23 || out_size != MTOK * DM || ws_size < WS_END) { fprintf(stderr, "kernel_launch: unexpected shapes (n_in %d out %d ws %zu)\n", n_in, out_size, ws_size); grid = -1; return; }
        int dev = 0, cus = 0, per_cu = 0;
        if (hipGetDevice(&dev) != hipSuccess || hipDeviceGetAttribute(&cus, hipDeviceAttributeMultiprocessorCount, dev) != hipSuccess) { grid = -1; return; }
        if (hipFuncSetAttribute((const void*)mega_fwd, hipFuncAttributeMaxDynamicSharedMemorySize, LDS_BYTES) != hipSuccess) { fprintf(stderr, "kernel_launch: hipFuncSetAttribute failed\n"); grid = -1; return; }
        if (hipOccupancyMaxActiveBlocksPerMultiprocessor(&per_cu, (const void*)mega_fwd, NWAVES * 64, LDS_BYTES) != hipSuccess || per_cu < 1) fprintf(stderr, "kernel_launch: occupancy query reports %d\n", per_cu);
        (void)hipGetLastError();
        grid = cus;
    }
    if (grid < 0) return;
    if (hipMemsetAsync((char*)d_ws + WS_CTL, 0, CTL_ZERO_BYTES, stream) != hipSuccess) return;
    Args a{};
    for (int i = 0; i < 23; ++i) a.in[i] = (const float*)d_in[i];
    a.out = (float*)d_out; a.ws = (unsigned char*)d_ws;
    if (MK_N_LAUNCHES == 1) { a.ph_lo = 0; a.ph_hi = N_PHASES; hipLaunchKernelGGL(mega_fwd, dim3(grid), dim3(NWAVES * 64), LDS_BYTES, stream, a); }
    else for (int p = 0; p < N_PHASES; ++p) { a.ph_lo = p; a.ph_hi = p + 1; hipLaunchKernelGGL(mega_fwd, dim3(grid), dim3(NWAVES * 64), LDS_BYTES, stream, a); }
}
```

```cpp
#include <hip/hip_runtime.h>
#include <hip/hip_bf16.h>
#include <cstdio>
#include <cstdint>
#include <cmath>

#define LAS __attribute__((address_space(3)))
#define GAS __attribute__((address_space(1)))
typedef unsigned short bf16_t;
typedef short bf16x8 __attribute__((ext_vector_type(8)));
typedef short s16x4 __attribute__((ext_vector_type(4)));
typedef _Float16 f16x8 __attribute__((ext_vector_type(8)));
typedef _Float16 f16x2 __attribute__((ext_vector_type(2)));
typedef float f32x4 __attribute__((ext_vector_type(4)));
typedef float f32x2 __attribute__((ext_vector_type(2)));
typedef float f32x16 __attribute__((ext_vector_type(16)));
typedef unsigned u32x4 __attribute__((ext_vector_type(4)));
typedef unsigned u32x2 __attribute__((ext_vector_type(2)));
typedef __bf16 bf16x2_t __attribute__((ext_vector_type(2)));

__device__ __forceinline__ unsigned cvtpk(float lo, float hi) { f32x2 v = {lo, hi}; bf16x2_t b = __builtin_convertvector(v, bf16x2_t); return __builtin_bit_cast(unsigned, b); }

namespace pg8 {
constexpr int BM = 256, BK = 64, HALF = 128, HTB = HALF * BK * 2, STAGE_BYTES = 8 * HTB, NXCD = 8, WGM = 8;
__host__ __device__ __forceinline__ int lds_byte(int r, int c) { const int st = (r >> 4) * 2 + (c >> 5), rr = r & 15, cc = c & 31, ob = rr * 64 + cc * 2; return st * 1024 + (ob ^ (((ob >> 9) & 1) << 5)); }
__host__ __device__ __forceinline__ void stage_rc(int b, int& R, int& C) { const int st = b / 1024, sb = b % 1024, swz = sb ^ (((sb >> 9) & 1) << 5); R = (st >> 1) * 16 + swz / 64; C = (st & 1) * 32 + (swz % 64) / 2; }
__host__ __device__ __forceinline__ int perm32(int rho) { const int n = rho >> 4, i = rho & 15; return 8 * (i >> 2) + 4 * n + (i & 3); }

struct Unit { int pm, pn; const char* a; const char* b; int e, loc0, cnt, pad; };


template <class Epi, class Sched, bool ALIGN_EPI = false>
__device__ __forceinline__ void gemm_phase(LAS unsigned char* lds, const int K, const Sched& S, const Epi& E) {
    int tid = threadIdx.x; asm volatile("" : "+v"(tid)); const int wid = __builtin_amdgcn_readfirstlane(tid >> 6), lane = tid & 63, wr = wid >> 2, wc = wid & 3, fr = lane & 15, fq = lane >> 4;
    const int nt = K / BK;
    Unit cur, nxt; int ui = 0;
    if (!S.next(0, cur)) return;
    int sR[2], sC[2];
#pragma unroll
    for (int i = 0; i < 2; ++i) stage_rc(tid * 16 + i * 8192, sR[i], sC[i]);
    unsigned vB[2][2], vA[2][2];
    LAS unsigned* xoff = (LAS unsigned*)(lds + 131072 + 2048) + tid * 4;
#pragma unroll
    for (int h = 0; h < 2; ++h)
#pragma unroll
        for (int i = 0; i < 2; ++i) { vB[h][i] = S.offB(h, sR[i], sC[i]); vA[h][i] = S.offA(cur, h, sR[i], sC[i]); }
    const size_t kstep = (size_t)(BK * 2);
    const unsigned ldsw = (unsigned)wid * 1024u;
    const int aoff = lds_byte(wr * 64 + fr, fq * 8), boff = lds_byte(wc * 32 + fr, fq * 8);
#define PG8_SA(b, h) (((b) * 2 + (h)) * HTB)
#define PG8_SB(b, h) ((4 + (b) * 2 + (h)) * HTB)
#define PG8_STAGE(bufoff, gbase, o0, o1) do { \
        __builtin_amdgcn_global_load_lds((const unsigned*)((const char*)(gbase) + (o0)), (LAS unsigned*)(lds + (bufoff) + ldsw), 16, 0, 0); \
        __builtin_amdgcn_global_load_lds((const unsigned*)((const char*)(gbase) + (o1)), (LAS unsigned*)(lds + (bufoff) + ldsw + 8192), 16, 0, 0); } while (0)
#define PG8_STA(bufoff, gbase, V, h) PG8_STAGE(bufoff, gbase, V[h][0], V[h][1])
#define PG8_LDA(dst, b, h) do { _Pragma("unroll") for (int m = 0; m < 4; ++m) _Pragma("unroll") for (int k = 0; k < 2; ++k) dst[m][k] = *(const LAS bf16x8*)(lds + PG8_SA(b, h) + aoff + m * 2048 + k * 1024); } while (0)
#define PG8_LDB(dst, b, h) do { _Pragma("unroll") for (int n = 0; n < 2; ++n) _Pragma("unroll") for (int k = 0; k < 2; ++k) dst[n][k] = *(const LAS bf16x8*)(lds + PG8_SB(b, h) + boff + n * 2048 + k * 1024); } while (0)
#define PG8_MMA(ai, bj, At, Bt) do { __builtin_amdgcn_s_setprio(1); _Pragma("unroll") for (int m = 0; m < 4; ++m) _Pragma("unroll") for (int n = 0; n < 2; ++n) _Pragma("unroll") for (int k = 0; k < 2; ++k) \
        acc[ai][bj][m][n] = __builtin_amdgcn_mfma_f32_16x16x32_bf16(Bt[n][k], At[m][k], acc[ai][bj][m][n], 0, 0, 0); __builtin_amdgcn_s_setprio(0); } while (0)
#define PG8_WAIT_V(n) asm volatile("s_waitcnt vmcnt(" #n ")" ::: "memory")
#define PG8_WAIT_L(n) asm volatile("s_waitcnt lgkmcnt(" #n ")" ::: "memory")
#define PG8_BAR __builtin_amdgcn_s_barrier()
#define PG8_SCHED __builtin_amdgcn_sched_barrier(0)
    f32x4 acc[2][2][4][2];
#pragma unroll
    for (int a = 0; a < 2; ++a)
#pragma unroll
        for (int b = 0; b < 2; ++b)
#pragma unroll
            for (int m = 0; m < 4; ++m)
#pragma unroll
                for (int n = 0; n < 2; ++n) acc[a][b][m][n] = (f32x4){0.f, 0.f, 0.f, 0.f};
    bf16x8 At[4][2], B0[2][2], B1[2][2];
    const char* cA = cur.a; const char* cB = cur.b;
    PG8_STA(PG8_SB(0, 0), cB, vB, 0); PG8_STA(PG8_SB(0, 1), cB, vB, 1); PG8_STA(PG8_SA(0, 0), cA, vA, 0); PG8_STA(PG8_SA(0, 1), cA, vA, 1);
    if (wr == 1) PG8_BAR;
    PG8_WAIT_V(2); PG8_BAR;
    PG8_STA(PG8_SB(1, 0), cB + kstep, vB, 0); PG8_STA(PG8_SA(1, 0), cA + kstep, vA, 0); PG8_STA(PG8_SB(1, 1), cB + kstep, vB, 1);
    PG8_WAIT_V(6); PG8_BAR;
    for (;;) {
        const bool has_next = S.next(ui + 1, nxt);
        const char* nA = has_next ? nxt.a : cA; const char* nB = has_next ? nxt.b : cB;
        if (Sched::GATHER) {
            if (has_next) {
#pragma unroll
                for (int i = 0; i < 2; ++i) { int t_ = tid; asm volatile("" : "+v"(t_)); int R_, C_; stage_rc(t_ * 16 + i * 8192, R_, C_);
#pragma unroll
                    for (int h = 0; h < 2; ++h) xoff[h * 2 + i] = S.offA(nxt, h, R_, C_); }
            }
        }
        for (int t = 0; t < nt; t += 2) {
            const bool last = (t == nt - 2);
            const char* a1 = cA + (size_t)(t + 1) * kstep;
            const char* a2 = last ? nA : cA + (size_t)(t + 2) * kstep; const char* b2 = last ? nB : cB + (size_t)(t + 2) * kstep;
            const char* a3 = a2 + kstep; const char* b3 = b2 + kstep;
            PG8_LDB(B0, 0, 0); PG8_LDB(B1, 0, 1); PG8_SCHED; PG8_LDA(At, 0, 0); PG8_STA(PG8_SA(1, 1), a1, vA, 1);
            PG8_WAIT_V(8); PG8_WAIT_L(0); PG8_BAR; PG8_MMA(0, 0, At, B0); PG8_MMA(0, 1, At, B1); PG8_BAR; PG8_SCHED;
            if (Sched::GATHER) { if (last && has_next) { vA[0][0] = xoff[0]; vA[0][1] = xoff[1]; vA[1][0] = xoff[2]; vA[1][1] = xoff[3]; } }
            PG8_LDA(At, 0, 1); PG8_STA(PG8_SB(0, 0), b2, vB, 0); PG8_STA(PG8_SB(0, 1), b2, vB, 1); PG8_STA(PG8_SA(0, 0), a2, vA, 0);
            PG8_WAIT_V(8); PG8_WAIT_L(0); PG8_BAR; PG8_MMA(1, 0, At, B0); PG8_MMA(1, 1, At, B1); PG8_BAR; PG8_SCHED;
            PG8_LDB(B0, 1, 0); PG8_LDB(B1, 1, 1); PG8_SCHED; PG8_LDA(At, 1, 0); PG8_STA(PG8_SA(0, 1), a2, vA, 1);
            PG8_WAIT_V(8); PG8_WAIT_L(0); PG8_BAR; PG8_MMA(0, 0, At, B0); PG8_MMA(0, 1, At, B1); PG8_BAR; PG8_SCHED;
            PG8_LDA(At, 1, 1); PG8_STA(PG8_SB(1, 0), b3, vB, 0); PG8_STA(PG8_SB(1, 1), b3, vB, 1); PG8_STA(PG8_SA(1, 0), a3, vA, 0);
            PG8_WAIT_V(8); PG8_WAIT_L(0); PG8_BAR; PG8_MMA(1, 0, At, B0); PG8_MMA(1, 1, At, B1); PG8_BAR; PG8_SCHED;
        }
        if constexpr (ALIGN_EPI) { if (wr == 0) PG8_BAR; }
        E(acc, cur, wr, wc, fr, fq);
        if (!has_next) break;
#pragma unroll
        for (int a = 0; a < 2; ++a)
#pragma unroll
            for (int b = 0; b < 2; ++b)
#pragma unroll
                for (int m = 0; m < 4; ++m)
#pragma unroll
                    for (int n = 0; n < 2; ++n) acc[a][b][m][n] = (f32x4){0.f, 0.f, 0.f, 0.f};
        cur = nxt; cA = nA; cB = nB; ++ui;
        if constexpr (ALIGN_EPI) { if (wr == 1) PG8_BAR; }
    }
    PG8_WAIT_V(0);
    if constexpr (!ALIGN_EPI) { if (wr == 0) PG8_BAR; }
    PG8_BAR;
#undef PG8_SA
#undef PG8_SB
#undef PG8_STAGE
#undef PG8_STA
#undef PG8_LDA
#undef PG8_LDB
#undef PG8_MMA
#undef PG8_WAIT_V
#undef PG8_WAIT_L
#undef PG8_BAR
#undef PG8_SCHED
}
}

constexpr int BATCH = 2, SEQ = 8192, DM = 1024, MTOK = BATCH * SEQ, INC = 3072;
constexpr int NEXP = 32, DEXP = 256, NWAVES = 8;
constexpr float EPS = 1e-6f, LOG2E = 1.4426950408889634f;
constexpr float LAMBDA_INIT = 0.2f;
constexpr int MAXTILES = 160, MAXSLOTS = MAXTILES * 256;

constexpr size_t MiB = 1u << 20;
constexpr size_t WS_CTL = 0, CTL_ZERO_BYTES = 64 * 1024;
constexpr size_t WS_MODV = 1 * MiB;
constexpr size_t WS_WR = 1 * MiB + 256 * 1024;
constexpr size_t WS_WIN = 2 * MiB;
constexpr size_t WS_WOUT = 8 * MiB;
constexpr size_t WS_W13 = 10 * MiB;
constexpr size_t WS_W2 = 42 * MiB;
constexpr size_t WS_HB = 58 * MiB;
constexpr size_t WS_QD = 90 * MiB, WS_KD = 106 * MiB, WS_VD = 122 * MiB, WS_QS = 138 * MiB, WS_KS = 154 * MiB, WS_VS = 170 * MiB;
constexpr size_t WS_AO = 186 * MiB;
constexpr size_t WS_ROUTE = 218 * MiB;
constexpr size_t WS_LIST = WS_ROUTE + 256 * 1024, WS_LISTW = WS_LIST + 2 * MiB;
constexpr size_t WS_HG = 90 * MiB;
constexpr size_t WS_Y = 110 * MiB;
constexpr size_t WS_END = 224 * MiB;
static_assert(WS_HG + (size_t)MAXSLOTS * 256 * 2 <= WS_Y && WS_Y + (size_t)MAXSLOTS * 1024 * 2 <= WS_ROUTE && WS_LISTW + 2 * MiB <= WS_END, "ws map");
constexpr int CW_CNT = 64;
constexpr int CW_QUEUE = 128;
constexpr int CW_BAR = 4096;

constexpr int RING_OFF = 0, RING_BYTES = 131072;
constexpr int LDSCTL_OFF = RING_BYTES, MISC_OFF = LDSCTL_OFF + 320;
constexpr int TPRE_OFF = LDSCTL_OFF + 1024;
constexpr int LDS_BYTES = 147456;

typedef GAS unsigned gu32;
#define RLX_AGENT __ATOMIC_RELAXED, __HIP_MEMORY_SCOPE_AGENT
#define LDS_WAIT() asm volatile("s_waitcnt lgkmcnt(0)" ::: "memory")
#define VM_WAIT() asm volatile("s_waitcnt vmcnt(0)" ::: "memory")

#define XB_TMO      128
#define XB_XCNT(j)  (256  + 64 * (j))
#define XB_XSUB(j)  (1280 + 64 * (j))
#define XB_XGEN(j)  (2304 + 64 * (j))
#define XB_TOP      3328
#define XB_TOPGEN   3392
#define XCD_BAR_WORDS 3456
#define XB_SPIN_CAP (1u << 20)
__device__ __forceinline__ unsigned xb_ld(unsigned* p)              { return __hip_atomic_load(p, __ATOMIC_RELAXED, __HIP_MEMORY_SCOPE_AGENT); }
__device__ __forceinline__ unsigned xb_add(unsigned* p, unsigned v) { return __hip_atomic_fetch_add(p, v, __ATOMIC_RELAXED, __HIP_MEMORY_SCOPE_AGENT); }
__device__ __forceinline__ unsigned xb_xcc_id() { return (unsigned)__builtin_amdgcn_s_getreg((3 << 11) | 20) & 0xFu; }
#define XB_SPIN(cond, bar) do { unsigned _sp = 0; while (cond) { __builtin_amdgcn_s_sleep(1); \
    if ((++_sp & 255u) == 0u) { if (xb_ld(&(bar)[XB_TMO])) break; if (_sp > XB_SPIN_CAP) { atomicAdd(&(bar)[XB_TMO], 1u); break; } } } } while (0)
struct XcdBarrier { unsigned* bar; unsigned x; volatile LAS unsigned* st; };
__device__ __forceinline__ XcdBarrier xcd_barrier_post(unsigned* bar, volatile LAS unsigned* st) {
    XcdBarrier b; b.bar = bar; b.x = xb_xcc_id(); b.st = st;
    if (threadIdx.x == 0) (void)xb_add(&bar[XB_XCNT(b.x)], 1u);
    return b;
}
__device__ __forceinline__ void xcd_barrier_complete(unsigned* bar, unsigned x, unsigned& nloc, unsigned& nx) {
    const unsigned G = gridDim.x * gridDim.y * gridDim.z;
    unsigned sum, cnt, mine, sp = 0u;
    for (;;) {
        sum = 0u; cnt = 0u; mine = 0u;
#pragma unroll
        for (unsigned j = 0; j < 16; ++j) { const unsigned c = xb_ld(&bar[XB_XCNT(j)]); sum += c; cnt += (c > 0u) ? 1u : 0u; mine = (j == x) ? c : mine; }
        if (sum == G) break;
        __builtin_amdgcn_s_sleep(1);
        if ((++sp & 255u) == 0u) { if (xb_ld(&bar[XB_TMO])) break; if (sp > XB_SPIN_CAP) { atomicAdd(&bar[XB_TMO], 1u); break; } }
    }
    nloc = mine > 0u ? mine : 1u; nx = cnt > 0u ? cnt : 1u;
}
__device__ __forceinline__ void xcd_barrier(const XcdBarrier& b) {
    asm volatile("s_waitcnt vmcnt(0)" ::: "memory");
    __syncthreads();
    if (threadIdx.x == 0) {
        unsigned* bar = b.bar;
        __builtin_amdgcn_s_waitcnt(0);
        unsigned nloc = b.st[0], nx = b.st[1];
        if (nloc == 0u) { xcd_barrier_complete(bar, b.x, nloc, nx); b.st[0] = nloc; b.st[1] = nx; }
        const unsigned old = xb_add(&bar[XB_XSUB(b.x)], 1u);
        const unsigned gen = old / nloc;
        if (old + 1u == (gen + 1u) * nloc) {
            __builtin_amdgcn_fence(__ATOMIC_RELEASE, "agent");
            asm volatile("s_waitcnt vmcnt(0)" ::: "memory");
            const unsigned og = xb_add(&bar[XB_TOP], 1u);
            const unsigned tg = og / nx;
            if (og + 1u == (tg + 1u) * nx) xb_add(&bar[XB_TOPGEN], 1u);
            else XB_SPIN(xb_ld(&bar[XB_TOPGEN]) == tg, bar);
            __builtin_amdgcn_fence(__ATOMIC_ACQUIRE, "agent");
            xb_add(&bar[XB_XGEN(b.x)], 1u);
            asm volatile("s_waitcnt vmcnt(0)" ::: "memory");
        } else {
            XB_SPIN(xb_ld(&bar[XB_XGEN(b.x)]) == gen, bar);
            __builtin_amdgcn_fence(__ATOMIC_ACQUIRE, "agent");
            asm volatile("s_waitcnt vmcnt(0)" ::: "memory");
        }
    }
    __syncthreads();
}

__device__ __forceinline__ float wave_sum(float v) {
#pragma unroll
    for (int o = 1; o < 64; o <<= 1) v += __shfl_xor(v, o);
    return v;
}
__device__ __forceinline__ float wave_max(float v) {
#pragma unroll
    for (int o = 1; o < 64; o <<= 1) v = fmaxf(v, __shfl_xor(v, o));
    return v;
}
__device__ __forceinline__ unsigned f2bf(float f) { unsigned u = __builtin_bit_cast(unsigned, f); return (u + 0x7fffu + ((u >> 16) & 1u)) >> 16; }
__device__ __forceinline__ unsigned pk2(float lo, float hi) { return f2bf(lo) | (f2bf(hi) << 16); }
__device__ __forceinline__ float bf2f(unsigned short h) { return __builtin_bit_cast(float, (unsigned)h << 16); }

struct DenseSched {
    static constexpr bool GATHER = false;
    int nM, nN, nwg, G, c, K; const char* A; const char* B; int bmode;
    bool perm;
    __device__ __forceinline__ bool next(int i, pg8::Unit& u) const {
        const long L = (long)i * G + c; if (L >= nwg) return false;
        int wgid = (int)L; { const int q = nwg / pg8::NXCD, r = nwg % pg8::NXCD, xcd = wgid % pg8::NXCD, off = wgid / pg8::NXCD; wgid = (xcd < r ? xcd * (q + 1) : r * (q + 1) + (xcd - r) * q) + off; }
        const int nig = pg8::WGM * nN, gid = wgid / nig, fm = gid * pg8::WGM, gsz = (nM - fm) < pg8::WGM ? (nM - fm) : pg8::WGM;
        u.pm = fm + ((wgid % nig) % gsz); u.pn = (wgid % nig) / gsz;
        u.a = A + (size_t)u.pm * 256 * K * 2; u.b = B + (size_t)u.pn * 256 * K * 2; u.e = 0; u.loc0 = 0; u.cnt = 0; u.pad = 0; return true;
    }
    __device__ __forceinline__ unsigned offA(const pg8::Unit&, int h, int R, int C) const { return (unsigned)((h * 128 + R) * K + C) * 2u; }
    __device__ __forceinline__ unsigned offB(int h, int R, int C) const {
        int row;
        if (bmode == 1) row = 64 * (R >> 5) + 32 * h + pg8::perm32(R & 31);
        else row = h * 128 + (perm ? ((R & ~31) + pg8::perm32(R & 31)) : R);
        return (unsigned)(row * K + C) * 2u;
    }
};

struct EpiQKV {
    bf16_t *Qd, *Kd, *Vd, *Qs, *Ks, *Vs; const float *gq, *gk;
    __device__ __forceinline__ void operator()(const f32x4 (&acc)[2][2][4][2], const pg8::Unit& u, int wr, int wc, int fr, int fq) const {
        asm volatile("" : "+v"(fr), "+v"(fq));
        const int pn = u.pn, sec = pn >> 1, G = 4 * (pn & 1) + wc;
        const int row0 = u.pm * 256 + wr * 64 + fr;
        const int b = row0 >> 13;
        float gv[2][2][4];
        if (sec < 2) { const float* g = sec == 0 ? gq : gk; const float sc = sec == 0 ? (0.125f * LOG2E) : 1.0f;
#pragma unroll
            for (int bj = 0; bj < 2; ++bj)
#pragma unroll
                for (int n = 0; n < 2; ++n) { const f32x4 t = *(const f32x4*)(g + 32 * bj + 8 * fq + 4 * n); gv[bj][n][0] = t[0] * sc; gv[bj][n][1] = t[1] * sc; gv[bj][n][2] = t[2] * sc; gv[bj][n][3] = t[3] * sc; }
        }
#pragma unroll
        for (int ai = 0; ai < 2; ++ai)
#pragma unroll
            for (int m = 0; m < 4; ++m) {
                const int row = row0 + ai * 128 + m * 16, s = row & (SEQ - 1);
                f32x4 v[2][2];
#pragma unroll
                for (int bj = 0; bj < 2; ++bj)
#pragma unroll
                    for (int n = 0; n < 2; ++n) v[bj][n] = acc[ai][bj][m][n];
                if (sec < 2) {
                    float ss = 0.f;
#pragma unroll
                    for (int bj = 0; bj < 2; ++bj)
#pragma unroll
                        for (int n = 0; n < 2; ++n) ss += (v[bj][n][0] * v[bj][n][0] + v[bj][n][1] * v[bj][n][1]) + (v[bj][n][2] * v[bj][n][2] + v[bj][n][3] * v[bj][n][3]);
                    ss += __shfl_xor(ss, 16); ss += __shfl_xor(ss, 32);
                    const float r = __builtin_amdgcn_rsqf(ss * (1.0f / 64.0f) + EPS);
#pragma unroll
                    for (int bj = 0; bj < 2; ++bj)
#pragma unroll
                        for (int n = 0; n < 2; ++n)
#pragma unroll
                            for (int i = 0; i < 4; ++i) v[bj][n][i] = v[bj][n][i] * r * gv[bj][n][i];
                } else if (sec == 3) {
#pragma unroll
                    for (int bj = 0; bj < 2; ++bj)
#pragma unroll
                        for (int n = 0; n < 2; ++n) v[bj][n] = v[bj][n] * (0.125f * LOG2E);
                }
#pragma unroll
                for (int bj = 0; bj < 2; ++bj) {
                    u32x4 w; w.x = cvtpk(v[bj][0][0], v[bj][0][1]); w.y = cvtpk(v[bj][0][2], v[bj][0][3]); w.z = cvtpk(v[bj][1][0], v[bj][1][1]); w.w = cvtpk(v[bj][1][2], v[bj][1][3]);
                    size_t off; bf16_t* base;
                    if (sec == 0 || sec == 3) {
                        base = sec == 0 ? Qd : Qs; off = ((size_t)(b * 8 + G) * SEQ + s) * 64 + 32 * bj + 8 * fq;
                    } else if (sec == 1 || sec == 4) {
                        base = sec == 1 ? Kd : Ks; off = ((((size_t)(b * 8 + G) * 128 + (s >> 6)) * 8 + 4 * bj + fq) * 64 + (s & 63)) * 8;
                    } else if (sec == 2) {
                        base = Vd; off = (((((size_t)(b * 4 + (G >> 1)) * 128 + (s >> 6)) * 4 + 2 * (G & 1) + bj) * 4 + ((s & 63) >> 4)) * 16 + (s & 15)) * 32 + 8 * fq;
                    } else {
                        base = Vs; off = (((((size_t)(b * 8 + G) * 128 + (s >> 6)) * 2 + bj) * 4 + ((s & 63) >> 4)) * 16 + (s & 15)) * 32 + 8 * fq;
                    }
                    *(u32x4*)(base + off) = w;
                }
            }
    }
};

struct EpiX1 {
    const float* x; float* out; const float* gt;
    __device__ __forceinline__ void operator()(const f32x4 (&acc)[2][2][4][2], const pg8::Unit& u, int wr, int wc, int fr, int fq) const {
        asm volatile("" : "+v"(fr), "+v"(fq));
        const int row0 = u.pm * 256 + wr * 64 + fr, b = row0 >> 13, col0 = u.pn * 256 + wc * 32 + 4 * fq;
        f32x4 g[2][2];
#pragma unroll
        for (int bj = 0; bj < 2; ++bj)
#pragma unroll
            for (int n = 0; n < 2; ++n) g[bj][n] = *(const f32x4*)(gt + (size_t)b * 6144 + col0 + bj * 128 + n * 16);
#pragma unroll
        for (int ai = 0; ai < 2; ++ai)
#pragma unroll
            for (int m = 0; m < 4; ++m) { const size_t off = (size_t)(row0 + ai * 128 + m * 16) * DM + col0;
#pragma unroll
                for (int bj = 0; bj < 2; ++bj)
#pragma unroll
                    for (int n = 0; n < 2; ++n) { const f32x4 xv = *(const f32x4*)(x + off + bj * 128 + n * 16); *(f32x4*)(out + off + bj * 128 + n * 16) = xv + g[bj][n] * acc[ai][bj][m][n]; } }
    }
};

struct MoeUpSched {
    static constexpr bool GATHER = true;
    int G, c; const LAS int* tpre; const LAS int* cnts; const int* list; const char* A; const char* B;
    __device__ __forceinline__ bool next(int i, pg8::Unit& u) const {
        const int L = i * G + c, T = tpre[32]; if (L >= 2 * T) return false;
        const int tau = L >> 1, pn = L & 1; int e = 0;
#pragma unroll 1
        for (int j = 1; j < 32; ++j) if (tpre[j] <= tau) e = j;
        u.pm = tau; u.pn = pn; u.e = e; u.loc0 = (tau - tpre[e]) * 256; u.cnt = cnts[e]; u.pad = 0;
        u.a = A; u.b = B + ((size_t)e * 512 + 128 * pn) * 1024 * 2; return true;
    }
    __device__ __forceinline__ unsigned offA(const pg8::Unit& u, int h, int R, int C) const {
        const int loc = u.loc0 + h * 128 + R; int tok = 0;
        if (loc < u.cnt) tok = list[u.e * MTOK + loc];
        return (unsigned)(tok * 1024 + C) * 2u;
    }
    __device__ __forceinline__ unsigned offB(int h, int R, int C) const { return (unsigned)((256 * h + (R & ~31) + pg8::perm32(R & 31)) * 1024 + C) * 2u; }
};
struct EpiAct {
    bf16_t* hg; const float* listw;
    __device__ __forceinline__ void operator()(const f32x4 (&acc)[2][2][4][2], const pg8::Unit& u, int wr, int wc, int fr, int fq) const {
        asm volatile("" : "+v"(fr), "+v"(fq));
        const int col0 = 128 * u.pn + 32 * wc + 8 * fq;
#pragma unroll
        for (int ai = 0; ai < 2; ++ai)
#pragma unroll
            for (int m = 0; m < 4; ++m) {
                const int rl = 128 * ai + 64 * wr + 16 * m + fr, loc = u.loc0 + rl;
                float w = 0.f; if (loc < u.cnt) w = listw[u.e * MTOK + loc];
                float o[8];
#pragma unroll
                for (int n = 0; n < 2; ++n)
#pragma unroll
                    for (int i = 0; i < 4; ++i) { const float a = acc[ai][0][m][n][i], g = acc[ai][1][m][n][i]; const float sg = a * __builtin_amdgcn_rcpf(1.0f + __builtin_amdgcn_exp2f(-a * LOG2E)); o[4 * n + i] = sg * g * w; }
                u32x4 q; q.x = cvtpk(o[0], o[1]); q.y = cvtpk(o[2], o[3]); q.z = cvtpk(o[4], o[5]); q.w = cvtpk(o[6], o[7]);
                *(u32x4*)(hg + ((size_t)u.pm * 256 + rl) * DEXP + col0) = q;
            }
    }
};
struct MoeDownSched {
    static constexpr bool GATHER = false;
    int G, c; const LAS int* tpre; const char* A; const char* B;
    __device__ __forceinline__ bool next(int i, pg8::Unit& u) const {
        const int L = i * G + c, T = tpre[32]; if (L >= 4 * T) return false;
        const int tau = L >> 2, pn = L & 3; int e = 0;
#pragma unroll 1
        for (int j = 1; j < 32; ++j) if (tpre[j] <= tau) e = j;
        u.pm = tau; u.pn = pn; u.e = e; u.loc0 = 0; u.cnt = 0; u.pad = 0;
        u.a = A + (size_t)tau * 256 * DEXP * 2; u.b = B + ((size_t)e * 1024 + 256 * pn) * DEXP * 2; return true;
    }
    __device__ __forceinline__ unsigned offA(const pg8::Unit&, int h, int R, int C) const { return (unsigned)((h * 128 + R) * DEXP + C) * 2u; }
    __device__ __forceinline__ unsigned offB(int h, int R, int C) const { return (unsigned)((h * 128 + (R & ~31) + pg8::perm32(R & 31)) * DEXP + C) * 2u; }
};
struct EpiY {
    bf16_t* y;
    __device__ __forceinline__ void operator()(const f32x4 (&acc)[2][2][4][2], const pg8::Unit& u, int wr, int wc, int fr, int fq) const {
        asm volatile("" : "+v"(fr), "+v"(fq));
        const int col0 = 256 * u.pn + 32 * wc + 8 * fq;
#pragma unroll
        for (int ai = 0; ai < 2; ++ai)
#pragma unroll
            for (int m = 0; m < 4; ++m) { bf16_t* rowp = y + ((size_t)u.pm * 256 + 128 * ai + 64 * wr + 16 * m + fr) * DM + col0;
#pragma unroll
                for (int bj = 0; bj < 2; ++bj) { const f32x4 v0 = acc[ai][bj][m][0], v1 = acc[ai][bj][m][1];
                    u32x4 w; w.x = cvtpk(v0[0], v0[1]); w.y = cvtpk(v0[2], v0[3]); w.z = cvtpk(v1[0], v1[1]); w.w = cvtpk(v1[2], v1[3]);
                    *(u32x4*)(rowp + bj * 128) = w; } }
    }
};

namespace att {
constexpr float ZTHR = 170.0f;
__device__ __forceinline__ int crow(int r, int hi) { return (r & 3) + 8 * (r >> 2) + 4 * hi; }
__device__ __forceinline__ s16x4 vtr(const LAS unsigned char* p) { return __builtin_bit_cast(s16x4, __builtin_amdgcn_ds_read_tr16_b64_v4i16((LAS s16x4*)p)); }
__device__ __forceinline__ bf16x8 cat8(s16x4 lo, s16x4 hi) { return (bf16x8){lo[0], lo[1], lo[2], lo[3], hi[0], hi[1], hi[2], hi[3]}; }
__device__ __forceinline__ float swap_add(float v) { auto rr = __builtin_amdgcn_permlane32_swap(__float_as_uint(v), __float_as_uint(v), false, false); return __uint_as_float(rr[0]) + __uint_as_float(rr[1]); }

struct AttnP {
    const bf16_t *Qd, *Kd, *Vd, *Qs, *Ks, *Vs; bf16_t* AO;
    const float *gq, *gk, *lq1, *lk1, *lq2, *lk2, *dog, *sog;
};

#define ATT_WAITBAR(N) asm volatile("s_waitcnt vmcnt(" #N ") lgkmcnt(0)\n\ts_barrier" ::: "memory")
#define GLDS16(src, dstoff) __builtin_amdgcn_global_load_lds((const unsigned*)(src), (LAS unsigned*)(lds + (dstoff) + ldsw), 16, 0, 0)
__device__ __forceinline__ void diff_unit(const AttnP& P, int b, int hh, int iq, LAS unsigned char* lds, float lam, float Mp) {
    int tid = threadIdx.x; asm volatile("" : "+v"(tid)); const int lane = tid & 63, r32 = lane & 31, hi = lane >> 5;
    const int wid = __builtin_amdgcn_readfirstlane(tid >> 6), mp = wid >> 2, rg = wid & 3;
    const int q0 = iq * 128, qw0 = q0 + 32 * rg, NT = 2 * (iq + 1);
    const int vh = 2 * hh + mp;
    const float slope = exp2f(-2.0f * (float)(hh + 1)) * LOG2E;
    const bf16_t* Qg = P.Qd + ((size_t)(b * 8 + vh) * SEQ + qw0 + r32) * 64;
    const unsigned char* K0g = (const unsigned char*)(P.Kd + (size_t)(b * 8 + 2 * hh) * SEQ * 64) + tid * 16;
    const unsigned char* K1g = (const unsigned char*)(P.Kd + (size_t)(b * 8 + 2 * hh + 1) * SEQ * 64) + tid * 16;
    const unsigned char* Vg = (const unsigned char*)(P.Vd + (size_t)(b * 4 + hh) * SEQ * 128) + tid * 16;
    bf16x8 qf[4];
#pragma unroll
    for (int s = 0; s < 4; ++s) qf[s] = *(const bf16x8*)(Qg + 16 * s + 8 * hi);
    const float lbase = slope * (float)(4 * hi - r32);
    f32x16 o[4];
#pragma unroll
    for (int d = 0; d < 4; ++d) o[d] = f32x16{};
    float lsum = 0.f;
    const unsigned ldsw = (unsigned)wid * 1024u;
#define DLOAD(j) do { const int so_ = ((j) & 3) * 32768; GLDS16(K0g + (size_t)(j) * 8192, so_); GLDS16(K1g + (size_t)(j) * 8192, so_ + 8192); \
        GLDS16(Vg + (size_t)(j) * 16384, so_ + 16384); GLDS16(Vg + (size_t)(j) * 16384 + 8192, so_ + 24576); } while (0)
#define DQK(P0, P1, j) do { const LAS unsigned char* Kb_ = lds + ((j) & 3) * 32768 + mp * 8192 + hi * 1024 + r32 * 16; \
        const float T0_ = -Mp - slope * (float)(qw0 - 64 * (j)) + lbase, T1_ = T0_ + 32.0f * slope; \
        _Pragma("unroll") for (int r = 0; r < 16; ++r) { const float cr = (float)((r & 3) + 8 * (r >> 2)); P0[r] = fmaf(slope, cr, T0_); P1[r] = fmaf(slope, cr, T1_); } \
        _Pragma("unroll") for (int s = 0; s < 4; ++s) { \
            const bf16x8 a0 = *(const LAS bf16x8*)(Kb_ + s * 2048), a1 = *(const LAS bf16x8*)(Kb_ + s * 2048 + 512); \
            P0 = __builtin_amdgcn_mfma_f32_32x32x16_bf16(a0, qf[s], P0, 0, 0, 0); \
            P1 = __builtin_amdgcn_mfma_f32_32x32x16_bf16(a1, qf[s], P1, 0, 0, 0); } } while (0)
    const int jlast = (qw0 + 31) >> 6;
    const float dwin = ZTHR / slope;
    const int jstart = max(0, (int)floorf(((float)q0 - dwin - 63.0f) * (1.0f / 64.0f)) + 1);
    const int jfirst = max(jstart, (int)floorf(((float)qw0 - dwin - 63.0f) * (1.0f / 64.0f)) + 1);
    DLOAD(jstart); if (jstart + 1 < NT) DLOAD(jstart + 1); if (jstart + 2 < NT) DLOAD(jstart + 2);
    if (jstart + 2 < NT) ATT_WAITBAR(8); else if (jstart + 1 < NT) ATT_WAITBAR(4); else ATT_WAITBAR(0);
    f32x16 p0, p1, n0, n1;
    if (jfirst == jstart) DQK(p0, p1, jstart);
    const int vlane = ((lane >> 4) & 1) * 32 + (lane & 3) * 8 + (4 * hi + ((lane & 15) >> 2)) * 64;
#define DBODY(DIAG, NEXT, j) do { \
        const LAS unsigned char* Vb = lds + ((j) & 3) * 32768 + 16384 + vlane; \
        if (NEXT) DQK(n0, n1, (j) + 1); \
        if (DIAG) { const int dq = qw0 + r32 - 64 * (j); \
            _Pragma("unroll") for (int r = 0; r < 16; ++r) { const int k0 = crow(r, hi); if (k0 > dq) p0[r] = -1e30f; if (k0 + 32 > dq) p1[r] = -1e30f; } } \
        _Pragma("unroll") for (int r = 0; r < 16; ++r) p0[r] = __builtin_amdgcn_exp2f(p0[r]); \
        float sa = 0.f; \
        _Pragma("unroll") for (int r = 0; r < 16; ++r) sa += p0[r]; \
        bf16x8 pf[2]; \
        _Pragma("unroll") for (int g = 0; g < 2; ++g) { u32x4 w; w.x = cvtpk(p0[8 * g + 0], p0[8 * g + 1]); w.y = cvtpk(p0[8 * g + 2], p0[8 * g + 3]); w.z = cvtpk(p0[8 * g + 4], p0[8 * g + 5]); w.w = cvtpk(p0[8 * g + 6], p0[8 * g + 7]); pf[g] = __builtin_bit_cast(bf16x8, w); } \
        _Pragma("unroll") for (int d = 0; d < 4; ++d) \
            _Pragma("unroll") for (int g = 0; g < 2; ++g) { const bf16x8 vf = cat8(vtr(Vb + d * 4096 + g * 1024), vtr(Vb + d * 4096 + g * 1024 + 512)); o[d] = __builtin_amdgcn_mfma_f32_32x32x16_bf16(vf, pf[g], o[d], 0, 0, 0); } \
        _Pragma("unroll") for (int r = 0; r < 16; ++r) p1[r] = __builtin_amdgcn_exp2f(p1[r]); \
        float sb = 0.f; \
        _Pragma("unroll") for (int r = 0; r < 16; ++r) sb += p1[r]; \
        lsum += sa + sb; \
        _Pragma("unroll") for (int g = 0; g < 2; ++g) { u32x4 w; w.x = cvtpk(p1[8 * g + 0], p1[8 * g + 1]); w.y = cvtpk(p1[8 * g + 2], p1[8 * g + 3]); w.z = cvtpk(p1[8 * g + 4], p1[8 * g + 5]); w.w = cvtpk(p1[8 * g + 6], p1[8 * g + 7]); pf[g] = __builtin_bit_cast(bf16x8, w); } \
        _Pragma("unroll") for (int d = 0; d < 4; ++d) \
            _Pragma("unroll") for (int g = 0; g < 2; ++g) { const bf16x8 vf = cat8(vtr(Vb + d * 4096 + (g + 2) * 1024), vtr(Vb + d * 4096 + (g + 2) * 1024 + 512)); o[d] = __builtin_amdgcn_mfma_f32_32x32x16_bf16(vf, pf[g], o[d], 0, 0, 0); } \
        if (NEXT) { p0 = n0; p1 = n1; } } while (0)
#define DTOP(j) do { if ((j) + 2 < NT) ATT_WAITBAR(4); else ATT_WAITBAR(0); if ((j) + 3 < NT) DLOAD((j) + 3); } while (0)
    int j = jstart;
    for (; j < jfirst; ++j) { DTOP(j); if (j + 1 == jfirst) DQK(p0, p1, j + 1); }
    for (; j < jlast; ++j) { DTOP(j); DBODY(false, true, j); }
    { DTOP(j); DBODY(true, false, j); ++j; }
    for (; j < NT; ++j) { DTOP(j); }
#undef DBODY
#undef DTOP
#undef DLOAD
#undef DQK
    ATT_WAITBAR(0);
    lsum = swap_add(lsum);
    const float inv = 1.0f / lsum;
    LAS float* exch = (LAS float*)lds + rg * 4096;
    if (mp == 1) {
#pragma unroll
        for (int d = 0; d < 4; ++d)
#pragma unroll
            for (int r = 0; r < 16; ++r) exch[(32 * d + crow(r, hi)) * 32 + r32] = o[d][r] * inv;
    }
    __syncthreads();
    if (mp == 0) {
        float ss = 0.f;
#pragma unroll
        for (int d = 0; d < 4; ++d)
#pragma unroll
            for (int r = 0; r < 16; ++r) { const float v = o[d][r] * inv - lam * exch[(32 * d + crow(r, hi)) * 32 + r32]; o[d][r] = v; ss += v * v; }
        ss = swap_add(ss);
        const float rr = __builtin_amdgcn_rsqf(ss * (1.0f / 128.0f) + EPS) * (1.0f - LAMBDA_INIT);
        LAS unsigned char* stg = lds + 65536 + rg * 8704;
#pragma unroll
        for (int d = 0; d < 4; ++d)
#pragma unroll
            for (int r = 0; r < 16; r += 2) { const int dd = 32 * d + crow(r, hi);
                *(LAS unsigned*)(stg + r32 * 272 + dd * 2) = cvtpk(o[d][r] * rr * P.dog[dd], o[d][r + 1] * rr * P.dog[dd + 1]); }
        LDS_WAIT();
        bf16_t* Og = P.AO + ((size_t)(b * SEQ) + qw0) * DM + 128 * hh;
#pragma unroll
        for (int it = 0; it < 8; ++it) { const int idx = it * 64 + lane, row = idx >> 4, ch = idx & 15;
            const u32x4 v = *(const LAS u32x4*)(stg + row * 272 + ch * 16); *(u32x4*)(Og + (size_t)row * DM + ch * 8) = v; }
    }
    __syncthreads();
}

__device__ __forceinline__ void sb_unit(const AttnP& P, int b, int h, int qb, LAS unsigned char* lds) {
    int tid = threadIdx.x; asm volatile("" : "+v"(tid)); const int lane = tid & 63, r32 = lane & 31, hi = lane >> 5;
    const int wid = __builtin_amdgcn_readfirstlane(tid >> 6);
    const int q0 = qb * 256, qw0 = q0 + 32 * wid, NT = 4 * (qb + 1);
    const bf16_t* Qg = P.Qs + ((size_t)(b * 8 + h) * SEQ + qw0 + r32) * 64;
    const unsigned char* Kg = (const unsigned char*)(P.Ks + (size_t)(b * 8 + h) * SEQ * 64) + tid * 16;
    const unsigned char* Vg = (const unsigned char*)(P.Vs + (size_t)(b * 8 + h) * SEQ * 64) + tid * 16;
    bf16x8 qf[4];
#pragma unroll
    for (int s = 0; s < 4; ++s) qf[s] = *(const bf16x8*)(Qg + 16 * s + 8 * hi);
    f16x8 atri[2], aone;
#pragma unroll
    for (int st = 0; st < 2; ++st)
#pragma unroll
        for (int jj = 0; jj < 8; ++jj) { const int j = 16 * st + 8 * (jj >> 2) + 4 * hi + (jj & 3); atri[st][jj] = (j >= r32) ? (_Float16)(-1.0f) : (_Float16)0.0f; }
#pragma unroll
    for (int jj = 0; jj < 8; ++jj) aone[jj] = (_Float16)(-1.0f);
    f32x16 o[2]; o[0] = f32x16{}; o[1] = f32x16{};
    f32x16 carry = f32x16{};
    const unsigned ldsw = (unsigned)wid * 1024u;
#define SLOAD(t) do { const int so_ = ((t) & 3) * 16384; const size_t go_ = (size_t)(NT - 1 - (t)) * 8192; GLDS16(Kg + go_, so_); GLDS16(Vg + go_, so_ + 8192); } while (0)
#define SQK(Z0, Z1, t) do { const LAS unsigned char* Kb_ = lds + ((t) & 3) * 16384 + hi * 1024 + r32 * 16; Z0 = f32x16{}; Z1 = f32x16{}; \
        _Pragma("unroll") for (int s = 0; s < 4; ++s) { \
            const bf16x8 a0 = *(const LAS bf16x8*)(Kb_ + s * 2048), a1 = *(const LAS bf16x8*)(Kb_ + s * 2048 + 512); \
            Z0 = __builtin_amdgcn_mfma_f32_32x32x16_bf16(a0, qf[s], Z0, 0, 0, 0); \
            Z1 = __builtin_amdgcn_mfma_f32_32x32x16_bf16(a1, qf[s], Z1, 0, 0, 0); } } while (0)
    const int jlast = (qw0 + 31) >> 6, tfirst = NT - 1 - jlast;
    LAS unsigned* ndone = (LAS unsigned*)(lds + 131072 + 512);
    if (tid == 0) *ndone = 0u;
    SLOAD(0); SLOAD(1); SLOAD(2);
    ATT_WAITBAR(4);
    f32x16 z0, z1, y0, y1;
    if (tfirst == 0) SQK(z0, z1, 0);
    const int vlane = ((lane >> 4) & 1) * 32 + (lane & 3) * 8 + (4 * hi + ((lane & 15) >> 2)) * 64;
#define SCAN(W, INC) do { f16x8 x0_, x1_; \
            _Pragma("unroll") for (int q = 0; q < 4; ++q) { const f16x2 t0_ = __builtin_bit_cast(f16x2, __builtin_amdgcn_cvt_pkrtz(W[2 * q], W[2 * q + 1])); x0_[2 * q] = t0_[0]; x0_[2 * q + 1] = t0_[1]; \
                const f16x2 t1_ = __builtin_bit_cast(f16x2, __builtin_amdgcn_cvt_pkrtz(W[8 + 2 * q], W[8 + 2 * q + 1])); x1_[2 * q] = t1_[0]; x1_[2 * q + 1] = t1_[1]; } \
            INC = __builtin_amdgcn_mfma_f32_32x32x16_f16(atri[0], x0_, carry, 0, 0, 0); \
            INC = __builtin_amdgcn_mfma_f32_32x32x16_f16(atri[1], x1_, INC, 0, 0, 0); \
            carry = __builtin_amdgcn_mfma_f32_32x32x16_f16(aone, x0_, carry, 0, 0, 0); \
            carry = __builtin_amdgcn_mfma_f32_32x32x16_f16(aone, x1_, carry, 0, 0, 0); } while (0)
#define SPV(A, BLK) do { _Pragma("unroll") for (int sp = 0; sp < 2; ++sp) { \
                u32x4 pw_; pw_.x = cvtpk(A[8 * sp + 0], A[8 * sp + 1]); pw_.y = cvtpk(A[8 * sp + 2], A[8 * sp + 3]); pw_.z = cvtpk(A[8 * sp + 4], A[8 * sp + 5]); pw_.w = cvtpk(A[8 * sp + 6], A[8 * sp + 7]); \
                const bf16x8 pf_ = __builtin_bit_cast(bf16x8, pw_); const int g_ = 2 * (BLK) + sp; \
                _Pragma("unroll") for (int d = 0; d < 2; ++d) { const bf16x8 vf_ = cat8(vtr(Vb + d * 4096 + g_ * 1024), vtr(Vb + d * 4096 + g_ * 1024 + 512)); \
                    o[d] = __builtin_amdgcn_mfma_f32_32x32x16_bf16(vf_, pf_, o[d], 0, 0, 0); } } } while (0)
#define SBODY(DIAG, NEXT, t) do { \
        const LAS unsigned char* Vb = lds + ((t) & 3) * 16384 + 8192 + vlane; \
        const int dq = qw0 + r32 - 64 * (NT - 1 - (t)); \
        if (NEXT) SQK(y0, y1, (t) + 1); \
        f32x16 w1_, w0_; \
        _Pragma("unroll") for (int r = 0; r < 16; ++r) { w1_[r] = __builtin_amdgcn_logf(1.0f + __builtin_amdgcn_exp2f(z1[r])); } \
        _Pragma("unroll") for (int r = 0; r < 16; ++r) { w0_[r] = __builtin_amdgcn_logf(1.0f + __builtin_amdgcn_exp2f(z0[r])); } \
        if (DIAG) { _Pragma("unroll") for (int r = 0; r < 16; ++r) { if (crow(r, hi) + 32 >= dq) w1_[r] = 0.f; if (crow(r, hi) >= dq) w0_[r] = 0.f; } } \
        f32x16 i1_, i0_; \
        SCAN(w1_, i1_); \
        SCAN(w0_, i0_); \
        _Pragma("unroll") for (int r = 0; r < 16; ++r) w1_[r] = __builtin_amdgcn_exp2f(z1[r] + i1_[r]); \
        if (DIAG) { _Pragma("unroll") for (int r = 0; r < 16; ++r) if (crow(r, hi) + 32 >= dq) w1_[r] = 0.f; } \
        SPV(w1_, 1); \
        _Pragma("unroll") for (int r = 0; r < 16; ++r) w0_[r] = __builtin_amdgcn_exp2f(z0[r] + i0_[r]); \
        if (DIAG) { _Pragma("unroll") for (int r = 0; r < 16; ++r) if (crow(r, hi) >= dq) w0_[r] = 0.f; } \
        SPV(w0_, 0); \
        if (NEXT) { z0 = y0; z1 = y1; } } while (0)
#define STOP(t) do { if ((t) + 2 < NT) ATT_WAITBAR(2); else ATT_WAITBAR(0); if ((t) + 3 < NT) SLOAD((t) + 3); } while (0)
    int t = 0; bool mydone = false;
    for (; t < tfirst; ++t) { STOP(t); if (t + 1 == tfirst) SQK(z0, z1, t + 1); }
    if (t + 1 < NT) { STOP(t); SBODY(true, true, t); ++t; mydone = __all(carry[0] <= -ZTHR);
        for (; t + 1 < NT && !mydone; ++t) { STOP(t); SBODY(false, true, t); mydone = __all(carry[0] <= -ZTHR); }
        if (!mydone) { STOP(t); SBODY(false, false, t); ++t; } }
    else { STOP(t); SBODY(true, false, t); ++t; }
    if (lane == 0) __hip_atomic_fetch_add(ndone, 1u, __ATOMIC_RELAXED, __HIP_MEMORY_SCOPE_WORKGROUP);
    for (; t < NT; ++t) { STOP(t); if (*(volatile LAS unsigned*)ndone == 8u) break; }
#undef SBODY
#undef STOP
#undef SCAN
#undef SPV
#undef SLOAD
#undef SQK
    ATT_WAITBAR(0);
    float ss = 0.f;
#pragma unroll
    for (int d = 0; d < 2; ++d)
#pragma unroll
        for (int r = 0; r < 16; ++r) ss += o[d][r] * o[d][r];
    ss = swap_add(ss);
    const float rr = __builtin_amdgcn_rsqf(ss * (1.0f / 64.0f) + EPS);
    LAS unsigned char* stg = lds + 65536 + wid * 4608;
#pragma unroll
    for (int d = 0; d < 2; ++d)
#pragma unroll
        for (int r = 0; r < 16; r += 2) { const int dd = 32 * d + crow(r, hi);
            *(LAS unsigned*)(stg + r32 * 144 + dd * 2) = cvtpk(o[d][r] * rr * P.sog[dd], o[d][r + 1] * rr * P.sog[dd + 1]); }
    LDS_WAIT();
    bf16_t* Og = P.AO + ((size_t)(b * SEQ) + qw0) * DM + 512 + 64 * h;
#pragma unroll
    for (int it = 0; it < 4; ++it) { const int idx = it * 64 + lane, row = idx >> 3, ch = idx & 7;
        const u32x4 v = *(const LAS u32x4*)(stg + row * 144 + ch * 16); *(u32x4*)(Og + (size_t)row * DM + ch * 8) = v; }
    __syncthreads();
}
#undef GLDS16
#undef ATT_WAITBAR
}

#ifndef MK_N_LAUNCHES
#define MK_N_LAUNCHES 1
#endif
constexpr int N_PHASES = 9;
struct Args { const float* in[23]; float* out; unsigned char* ws; int ph_lo, ph_hi; };

__device__ __forceinline__ void p0_transpose_item(const float* W, int K, int N, bf16_t* WT, int row_off, LAS float* scr, int item, int lane) {
    const int nblk = N / 32, kb = item / nblk, nb = item % nblk, k0 = 64 * kb, n0 = 32 * nb;
#pragma unroll 8
    for (int i = 0; i < 32; ++i) { const int kk = 2 * i + (lane >> 5); scr[kk * 33 + (lane & 31)] = W[(size_t)(k0 + kk) * N + n0 + (lane & 31)]; }
    LDS_WAIT(); asm volatile("" ::: "memory");
    const int c = lane & 7;
#pragma unroll
    for (int j = 0; j < 4; ++j) { const int n = (lane >> 3) + 8 * j; const LAS float* s = scr + (8 * c) * 33 + n;
        u32x4 o; o.x = pk2(s[0 * 33], s[1 * 33]); o.y = pk2(s[2 * 33], s[3 * 33]); o.z = pk2(s[4 * 33], s[5 * 33]); o.w = pk2(s[6 * 33], s[7 * 33]);
        *(u32x4*)(WT + (size_t)(row_off + n0 + n) * K + k0 + 8 * c) = o; }
    LDS_WAIT(); asm volatile("" ::: "memory");
}

__global__ void __launch_bounds__(NWAVES * 64, 2) mega_fwd(Args args) {
    extern __shared__ __attribute__((aligned(16))) unsigned char lds_raw[];
    LAS unsigned char* lds = (LAS unsigned char*)lds_raw;
    volatile LAS unsigned* MISC = (volatile LAS unsigned*)(lds + MISC_OFF);
    const int G = gridDim.x; const int bx = blockIdx.x;
#define PHASE_IDS() int tid = threadIdx.x; asm volatile("" : "+v"(tid)); const int lane = tid & 63, wave = __builtin_amdgcn_readfirstlane(tid >> 6); const int gw = vcu * NWAVES + wave, NGW = G * NWAVES; (void)lane; (void)gw; (void)NGW
    const int vcu = (G % 8 == 0) ? (bx % 8) * (G / 8) + bx / 8 : bx;
    unsigned char* ws = args.ws;
    unsigned* ctl = (unsigned*)(ws + WS_CTL);
    float* modv = (float*)(ws + WS_MODV);
    bf16_t* Wr_t = (bf16_t*)(ws + WS_WR); bf16_t* Win_t = (bf16_t*)(ws + WS_WIN); bf16_t* Wout_t = (bf16_t*)(ws + WS_WOUT);
    bf16_t* W13_t = (bf16_t*)(ws + WS_W13); bf16_t* W2_t = (bf16_t*)(ws + WS_W2); bf16_t* HB = (bf16_t*)(ws + WS_HB);
    bf16_t* AO = (bf16_t*)(ws + WS_AO); bf16_t* HG = (bf16_t*)(ws + WS_HG); bf16_t* Y = (bf16_t*)(ws + WS_Y);
    int* tokinfo = (int*)(ws + WS_ROUTE); int* list = (int*)(ws + WS_LIST); float* listw = (float*)(ws + WS_LISTW);
    const float* x = args.in[0]; float* out = args.out;

    for (int u = threadIdx.x; u < (LDS_BYTES - LDSCTL_OFF) / 4; u += NWAVES * 64) ((LAS unsigned*)(lds + LDSCTL_OFF))[u] = 0u;
    __syncthreads();
    XcdBarrier bar; bar.bar = ctl + CW_BAR; bar.x = 0; bar.st = nullptr;
    if (MK_N_LAUNCHES == 1) bar = xcd_barrier_post(ctl + CW_BAR, MISC + 8);
#define GRID_BAR() do { if (MK_N_LAUNCHES == 1) xcd_barrier(bar); } while (0)
    const int lo = args.ph_lo, hi = args.ph_hi;
#ifndef PHMASK
#define PHMASK 0x1ff
#endif
#define IN(k) ((((PHMASK) >> (k)) & 1) && lo <= (k) && (k) < hi)
#define BOTH(k) (IN(k) && IN((k) + 1))

    if (IN(0)) {
        PHASE_IDS();
        for (int item = vcu; item < 192; item += G) {
            LAS float* sl = (LAS float*)lds;
            LAS float* red = (LAS float*)(lds + 8192);
            for (int i = tid; i < 2048; i += 512) { const float c = args.in[1][i]; sl[i] = c / (1.0f + __expf(-c)); }
            __syncthreads();
            const int n0 = 32 * item, col = lane & 31, kh = lane >> 5;
            const float* W = args.in[2] + n0 + col;
            float a0 = 0.f, a1 = 0.f;
#pragma unroll 16
            for (int i = 0; i < 64; ++i) { const int k = 128 * wave + 2 * i + kh; const float w = W[(size_t)k * 6144]; a0 += sl[k] * w; a1 += sl[1024 + k] * w; }
            a0 += __shfl_xor(a0, 32); a1 += __shfl_xor(a1, 32);
            if (lane < 32) { red[(wave * 2 + 0) * 32 + col] = a0; red[(wave * 2 + 1) * 32 + col] = a1; }
            __syncthreads();
            if (tid < 64) { const int b = tid >> 5, c2 = tid & 31; float v = 0.f;
#pragma unroll
                for (int w = 0; w < 8; ++w) v += red[(w * 2 + b) * 32 + c2];
                const int n = n0 + c2, j = n >> 10, k = n & 1023; v += args.in[3][n];
                if (j == 1) v = args.in[4][k] * (1.0f + v);
                if (j == 4) v = args.in[15][k] * (1.0f + v);
                modv[(b * 6 + j) * 1024 + k] = v; }
            __syncthreads();
        }
        if (vcu == G - 1) {
            for (int idx = tid; idx < 65536; idx += 512) { const int j = idx >> 10, k = idx & 1023; float v = 0.f;
                if (j < 4) v = args.in[16][k * 4 + j]; else if (j < 36) v = args.in[18][(size_t)((j - 4) >> 3) * 8192 + k * 8 + ((j - 4) & 7)];
                Wr_t[idx] = (bf16_t)f2bf(v); }
        }
        LAS float* scr = (LAS float*)(lds + wave * 16384);
        constexpr int I_IN = 16 * 96, I_OUT = 16 * 32, I_E = 128, NITEMS = I_IN + I_OUT + 3 * 32 * I_E;
        for (int it = gw; it < NITEMS; it += NGW) {
            int r = it;
            if (r < I_IN) { p0_transpose_item(args.in[5], 1024, 3072, Win_t, 0, scr, r, lane); continue; } r -= I_IN;
            if (r < I_OUT) { p0_transpose_item(args.in[14], 1024, 1024, Wout_t, 0, scr, r, lane); continue; } r -= I_OUT;
            if (r < 32 * I_E) { const int e = r / I_E; p0_transpose_item(args.in[20] + (size_t)e * 1024 * 256, 1024, 256, W13_t + (size_t)e * 512 * 1024, 0, scr, r % I_E, lane); continue; } r -= 32 * I_E;
            if (r < 32 * I_E) { const int e = r / I_E; p0_transpose_item(args.in[21] + (size_t)e * 1024 * 256, 1024, 256, W13_t + (size_t)e * 512 * 1024, 256, scr, r % I_E, lane); continue; } r -= 32 * I_E;
            { const int e = r / I_E; p0_transpose_item(args.in[22] + (size_t)e * 256 * 1024, 256, 1024, W2_t + (size_t)e * 1024 * 256, 0, scr, r % I_E, lane); }
        }
        if (BOTH(0)) GRID_BAR();
    }

    if (IN(1)) {
        PHASE_IDS();
        for (int m = gw; m < MTOK; m += NGW) {
            const int b = m >> 13;
            const f32x4* xr = (const f32x4*)(x + (size_t)m * DM) + lane;
            const f32x4* gm = (const f32x4*)(modv + (b * 6 + 1) * 1024) + lane; const f32x4* sh = (const f32x4*)(modv + (b * 6 + 0) * 1024) + lane;
            f32x4 v[4]; float s = 0.f;
#pragma unroll
            for (int j = 0; j < 4; ++j) { v[j] = xr[64 * j]; s += (v[j].x * v[j].x + v[j].y * v[j].y) + (v[j].z * v[j].z + v[j].w * v[j].w); }
            const float rstd = __builtin_amdgcn_rsqf(wave_sum(s) * (1.f / DM) + EPS);
            unsigned long long* o8 = (unsigned long long*)(HB + (size_t)m * DM) + lane;
#pragma unroll
            for (int j = 0; j < 4; ++j) { const f32x4 g = gm[64 * j], t = sh[64 * j]; const f32x4 hq = v[j] * rstd * g + t;
                o8[64 * j] = (unsigned long long)cvtpk(hq.x, hq.y) | ((unsigned long long)cvtpk(hq.z, hq.w) << 32); }
        }
        if (BOTH(1)) GRID_BAR();
    }

    if (IN(2)) {
        DenseSched S; S.nM = MTOK / 256; S.nN = INC / 256; S.nwg = S.nM * S.nN; S.G = G; S.c = bx; S.K = DM; S.A = (const char*)HB; S.B = (const char*)Win_t; S.bmode = 1; S.perm = true;
        EpiQKV E{(bf16_t*)(ws + WS_QD), (bf16_t*)(ws + WS_KD), (bf16_t*)(ws + WS_VD), (bf16_t*)(ws + WS_QS), (bf16_t*)(ws + WS_KS), (bf16_t*)(ws + WS_VS), args.in[6], args.in[7]};
        pg8::gemm_phase<EpiQKV, DenseSched, true>(lds + RING_OFF, DM, S, E);
        if (BOTH(2)) GRID_BAR();
    }

    if (IN(3)) {
        PHASE_IDS();
        att::AttnP P{(const bf16_t*)(ws + WS_QD), (const bf16_t*)(ws + WS_KD), (const bf16_t*)(ws + WS_VD), (const bf16_t*)(ws + WS_QS), (const bf16_t*)(ws + WS_KS), (const bf16_t*)(ws + WS_VS), AO,
                     args.in[6], args.in[7], args.in[8], args.in[9], args.in[10], args.in[11], args.in[12], args.in[13]};
        const float e1 = wave_sum(P.lq1[lane] * P.lk1[lane]), e2 = wave_sum(P.lq2[lane] * P.lk2[lane]);
        const float lam = __expf(e1) - __expf(e2) + LAMBDA_INIT;
        const float Mp = 8.0f * wave_max(fabsf(P.gq[lane])) * wave_max(fabsf(P.gk[lane])) * LOG2E;
        LAS unsigned* qslot = (LAS unsigned*)(lds + LDSCTL_OFF + 516);
        for (;;) {
            if (tid == 0) *qslot = atomicAdd(ctl + CW_QUEUE, 1u);
            __syncthreads();
            const int u = (int)*(volatile LAS unsigned*)qslot;
            if (u >= 1024) break;
            if (u < 512) { const int g2 = u >> 8, r = u & 255, iq = 63 - (r >> 2), hs = (r >> 1) & 1, b = r & 1, hh = g2 == 0 ? 3 - hs : 1 - hs; att::diff_unit(P, b, hh, iq, lds, lam, Mp); }
            else { const int s = u - 512, qb = 31 - (s >> 4), bh = s & 15; att::sb_unit(P, bh >> 3, bh & 7, qb, lds); }
        }
        if (BOTH(3)) GRID_BAR();
    }

    if (IN(4)) {
        DenseSched S; S.nM = MTOK / 256; S.nN = DM / 256; S.nwg = S.nM * S.nN; S.G = G; S.c = bx; S.K = DM; S.A = (const char*)AO; S.B = (const char*)Wout_t; S.bmode = 0; S.perm = false;
        EpiX1 E{x, out, modv + 2 * 1024};
        pg8::gemm_phase<EpiX1, DenseSched, false>(lds + RING_OFF, DM, S, E);
        if (BOTH(4)) GRID_BAR();
    }

    if (IN(5)) {
        PHASE_IDS();
        LAS unsigned char* At = lds;
        LAS float* red = (LAS float*)(lds + 66560);
        for (int T = vcu; T < MTOK / 32; T += G) {
            const int row0 = T * 32, b = row0 >> 13;
#pragma unroll 1
            for (int rr = 0; rr < 4; ++rr) {
                const int rl = 4 * wave + rr, m = row0 + rl;
                const f32x4* xr = (const f32x4*)(out + (size_t)m * DM) + lane;
                const f32x4* gm = (const f32x4*)(modv + (b * 6 + 4) * 1024) + lane; const f32x4* sh = (const f32x4*)(modv + (b * 6 + 3) * 1024) + lane;
                f32x4 v[4]; float s = 0.f;
#pragma unroll
                for (int j = 0; j < 4; ++j) { v[j] = xr[64 * j]; s += (v[j].x * v[j].x + v[j].y * v[j].y) + (v[j].z * v[j].z + v[j].w * v[j].w); }
                const float rstd = __builtin_amdgcn_rsqf(wave_sum(s) * (1.f / DM) + EPS);
                unsigned long long* o8 = (unsigned long long*)(HB + (size_t)m * DM) + lane;
#pragma unroll
                for (int j = 0; j < 4; ++j) { const f32x4 g = gm[64 * j], t = sh[64 * j]; const f32x4 hq = v[j] * rstd * g + t;
                    const unsigned long long pk = (unsigned long long)cvtpk(hq.x, hq.y) | ((unsigned long long)cvtpk(hq.z, hq.w) << 32);
                    o8[64 * j] = pk; *(LAS unsigned long long*)(At + rl * 2064 + (4 * lane + 256 * j) * 2) = pk; }
            }
            __syncthreads();
            {
                f32x4 acc[2][3];
#pragma unroll
                for (int mf = 0; mf < 2; ++mf)
#pragma unroll
                    for (int nf = 0; nf < 3; ++nf) acc[mf][nf] = (f32x4){0.f, 0.f, 0.f, 0.f};
                const int fr = lane & 15, fq = lane >> 4;
#pragma unroll
                for (int ks = 0; ks < 4; ++ks) {
                    const int k0 = 128 * wave + 32 * ks + 8 * fq;
                    bf16x8 af[2], bfm[3];
#pragma unroll
                    for (int mf = 0; mf < 2; ++mf) af[mf] = *(const LAS bf16x8*)(At + (16 * mf + fr) * 2064 + k0 * 2);
#pragma unroll
                    for (int nf = 0; nf < 3; ++nf) bfm[nf] = *(const bf16x8*)(Wr_t + (size_t)(16 * nf + fr) * 1024 + k0);
#pragma unroll
                    for (int mf = 0; mf < 2; ++mf)
#pragma unroll
                        for (int nf = 0; nf < 3; ++nf) acc[mf][nf] = __builtin_amdgcn_mfma_f32_16x16x32_bf16(af[mf], bfm[nf], acc[mf][nf], 0, 0, 0);
                }
#pragma unroll
                for (int mf = 0; mf < 2; ++mf)
#pragma unroll
                    for (int nf = 0; nf < 3; ++nf)
#pragma unroll
                        for (int i = 0; i < 4; ++i) red[(wave * 32 + 16 * mf + 4 * fq + i) * 48 + 16 * nf + fr] = acc[mf][nf][i];
            }
            __syncthreads();
            if (tid < 32) {
                const int m = row0 + tid;
                float gl[4];
#pragma unroll
                for (int c = 0; c < 4; ++c) { float v = args.in[17][c];
#pragma unroll
                    for (int w = 0; w < 8; ++w) v += red[(w * 32 + tid) * 48 + c]; gl[c] = v; }
                int gs = 0; float gmax = gl[0];
#pragma unroll
                for (int c = 1; c < 4; ++c) if (gl[c] > gmax) { gmax = gl[c]; gs = c; }
                float den = 0.f;
#pragma unroll
                for (int c = 0; c < 4; ++c) den += __expf(gl[c] - gmax);
                const float gate = 1.0f / den;
                float el[8];
#pragma unroll
                for (int e = 0; e < 8; ++e) { float v = args.in[19][gs * 8 + e];
#pragma unroll
                    for (int w = 0; w < 8; ++w) v += red[(w * 32 + tid) * 48 + 4 + gs * 8 + e]; el[e] = v; }
                int e0 = 0; float t0 = el[0];
#pragma unroll
                for (int e = 1; e < 8; ++e) if (el[e] > t0) { t0 = el[e]; e0 = e; }
                int e1 = -1; float t1 = -INFINITY;
#pragma unroll
                for (int e = 0; e < 8; ++e) if (e != e0 && el[e] > t1) { t1 = el[e]; e1 = e; }
                const float w0 = 1.0f / (1.0f + __expf(t1 - t0)), w1 = 1.0f - w0;
                const int ge0 = gs * 8 + e0, ge1 = gs * 8 + e1;
                const int p0 = (int)atomicAdd(ctl + CW_CNT + ge0, 1u), p1 = (int)atomicAdd(ctl + CW_CNT + ge1, 1u);
                list[ge0 * MTOK + p0] = m; listw[ge0 * MTOK + p0] = gate * w0;
                list[ge1 * MTOK + p1] = m; listw[ge1 * MTOK + p1] = gate * w1;
                *(int4*)(tokinfo + 4 * m) = make_int4(ge0, p0, ge1, p1);
            }
            __syncthreads();
        }
        if (BOTH(5)) GRID_BAR();
    }

    LAS int* tpre = (LAS int*)(lds + TPRE_OFF); LAS int* cnts = tpre + 64;
    if (IN(6) || IN(7) || IN(8)) {
        if (threadIdx.x == 0) { int acc = 0; for (int e = 0; e < 32; ++e) { const int c = (int)__hip_atomic_load(ctl + CW_CNT + e, RLX_AGENT); cnts[e] = c; tpre[e] = acc; acc += (c + 255) >> 8; } tpre[32] = acc; }
        __syncthreads();
    }
    if (IN(6)) {
        MoeUpSched S{G, bx, tpre, cnts, list, (const char*)HB, (const char*)W13_t};
        EpiAct E{HG, listw};
        pg8::gemm_phase<EpiAct, MoeUpSched, false>(lds + RING_OFF, DM, S, E);
        if (BOTH(6)) GRID_BAR();
    }
    if (IN(7)) {
        MoeDownSched S{G, bx, tpre, (const char*)HG, (const char*)W2_t};
        EpiY E{Y};
        pg8::gemm_phase<EpiY, MoeDownSched, false>(lds + RING_OFF, DEXP, S, E);
        if (BOTH(7)) GRID_BAR();
    }
    if (IN(8)) {
        PHASE_IDS();
        int tb = 0; if (lane < 32) tb = tpre[lane] * 256;
        for (int m = gw; m < MTOK; m += NGW) {
            const int b = m >> 13; const int4 inf = *(const int4*)(tokinfo + 4 * m);
            const int s0 = __shfl(tb, inf.x) + inf.y, s1 = __shfl(tb, inf.z) + inf.w;
            f32x4* orow = (f32x4*)(out + (size_t)m * DM) + lane; const f32x4* gt = (const f32x4*)(modv + (b * 6 + 5) * 1024) + lane;
            const u32x2* y0 = (const u32x2*)(Y + (size_t)s0 * DM) + lane; const u32x2* y1 = (const u32x2*)(Y + (size_t)s1 * DM) + lane;
#pragma unroll
            for (int j = 0; j < 4; ++j) { const u32x2 a = y0[64 * j], c = y1[64 * j]; const f32x4 g = gt[64 * j]; f32x4 xv = orow[64 * j];
                f32x4 ys; ys.x = __uint_as_float(a.x << 16) + __uint_as_float(c.x << 16); ys.y = __uint_as_float(a.x & 0xffff0000u) + __uint_as_float(c.x & 0xffff0000u);
                ys.z = __uint_as_float(a.y << 16) + __uint_as_float(c.y << 16); ys.w = __uint_as_float(a.y & 0xffff0000u) + __uint_as_float(c.y & 0xffff0000u);
                orow[64 * j] = xv + g * ys; }
        }
    }
#undef IN
#undef BOTH
#undef GRID_BAR
}

extern "C" void kernel_launch(void* const* d_in, const int* in_sizes, int n_in, void* d_out, int out_size, void* d_ws, size_t ws_size, hipStream_t stream) {
    static int grid = 0;
    if (grid == 0) {
        if (n_in != 23 || out_size != MTOK * DM || ws_size < WS_END) { fprintf(stderr, "kernel_launch: unexpected shapes (n_in %d out %d ws %zu)\n", n_in, out_size, ws_size); grid = -1; return; }
        int dev = 0, cus = 0, per_cu = 0;
        if (hipGetDevice(&dev) != hipSuccess || hipDeviceGetAttribute(&cus, hipDeviceAttributeMultiprocessorCount, dev) != hipSuccess) { grid = -1; return; }
        if (hipFuncSetAttribute((const void*)mega_fwd, hipFuncAttributeMaxDynamicSharedMemorySize, LDS_BYTES) != hipSuccess) { fprintf(stderr, "kernel_launch: hipFuncSetAttribute failed\n"); grid = -1; return; }
        if (hipOccupancyMaxActiveBlocksPerMultiprocessor(&per_cu, (const void*)mega_fwd, NWAVES * 64, LDS_BYTES) != hipSuccess || per_cu < 1) fprintf(stderr, "kernel_launch: occupancy query reports %d\n", per_cu);
        (void)hipGetLastError();
        grid = cus;
    }
    if (grid < 0) return;
    if (hipMemsetAsync((char*)d_ws + WS_CTL, 0, CTL_ZERO_BYTES, stream) != hipSuccess) return;
    Args a{};
    for (int i = 0; i < 23; ++i) a.in[i] = (const float*)d_in[i];
    a.out = (float*)d_out; a.ws = (unsigned char*)d_ws;
    if (MK_N_LAUNCHES == 1) { a.ph_lo = 0; a.ph_hi = N_PHASES; hipLaunchKernelGGL(mega_fwd, dim3(grid), dim3(NWAVES * 64), LDS_BYTES, stream, a); }
    else for (int p = 0; p < N_PHASES; ++p) { a.ph_lo = p; a.ph_hi = p + 1; hipLaunchKernelGGL(mega_fwd, dim3(grid), dim3(NWAVES * 64), LDS_BYTES, stream, a); }
}
```

```cpp
#include <hip/hip_runtime.h>
#include <hip/hip_bf16.h>
#include <cstdio>
#include <cstdint>
#include <cmath>

#define LAS __attribute__((address_space(3)))
#define GAS __attribute__((address_space(1)))
typedef unsigned short bf16_t;
typedef short bf16x8 __attribute__((ext_vector_type(8)));
typedef short s16x4 __attribute__((ext_vector_type(4)));
typedef _Float16 f16x8 __attribute__((ext_vector_type(8)));
typedef _Float16 f16x2 __attribute__((ext_vector_type(2)));
typedef float f32x4 __attribute__((ext_vector_type(4)));
typedef float f32x2 __attribute__((ext_vector_type(2)));
typedef float f32x16 __attribute__((ext_vector_type(16)));
typedef unsigned u32x4 __attribute__((ext_vector_type(4)));
typedef unsigned u32x2 __attribute__((ext_vector_type(2)));
typedef __bf16 bf16x2_t __attribute__((ext_vector_type(2)));

__device__ __forceinline__ unsigned cvtpk(float lo, float hi) { f32x2 v = {lo, hi}; bf16x2_t b = __builtin_convertvector(v, bf16x2_t); return __builtin_bit_cast(unsigned, b); }

namespace pg8 {
constexpr int BM = 256, BK = 64, HALF = 128, HTB = HALF * BK * 2, STAGE_BYTES = 8 * HTB, NXCD = 8, WGM = 8;
__host__ __device__ __forceinline__ int lds_byte(int r, int c) { const int st = (r >> 4) * 2 + (c >> 5), rr = r & 15, cc = c & 31, ob = rr * 64 + cc * 2; return st * 1024 + (ob ^ (((ob >> 9) & 1) << 5)); }
__host__ __device__ __forceinline__ void stage_rc(int b, int& R, int& C) { const int st = b / 1024, sb = b % 1024, swz = sb ^ (((sb >> 9) & 1) << 5); R = (st >> 1) * 16 + swz / 64; C = (st & 1) * 32 + (swz % 64) / 2; }
__host__ __device__ __forceinline__ int perm32(int rho) { const int n = rho >> 4, i = rho & 15; return 8 * (i >> 2) + 4 * n + (i & 3); }

struct Unit { int pm, pn; const char* a; const char* b; int e, loc0, cnt, pad; };


template <class Epi, class Sched, bool ALIGN_EPI = false>
__device__ __forceinline__ void gemm_phase(LAS unsigned char* lds, const int K, const Sched& S, const Epi& E) {
    int tid = threadIdx.x; asm volatile("" : "+v"(tid)); const int wid = __builtin_amdgcn_readfirstlane(tid >> 6), lane = tid & 63, wr = wid >> 2, wc = wid & 3, fr = lane & 15, fq = lane >> 4;
    const int nt = K / BK;
    Unit cur, nxt; int ui = 0;
    if (!S.next(0, cur)) return;
    int sR[2], sC[2];
#pragma unroll
    for (int i = 0; i < 2; ++i) stage_rc(tid * 16 + i * 8192, sR[i], sC[i]);
    unsigned vB[2][2], vA[2][2];
    LAS unsigned* xoff = (LAS unsigned*)(lds + 131072 + 2048) + tid * 4;
#pragma unroll
    for (int h = 0; h < 2; ++h)
#pragma unroll
        for (int i = 0; i < 2; ++i) { vB[h][i] = S.offB(h, sR[i], sC[i]); vA[h][i] = S.offA(cur, h, sR[i], sC[i]); }
    const size_t kstep = (size_t)(BK * 2);
    const unsigned ldsw = (unsigned)wid * 1024u;
    const int aoff = lds_byte(wr * 64 + fr, fq * 8), boff = lds_byte(wc * 32 + fr, fq * 8);
#define PG8_SA(b, h) (((b) * 2 + (h)) * HTB)
#define PG8_SB(b, h) ((4 + (b) * 2 + (h)) * HTB)
#define PG8_STAGE(bufoff, gbase, o0, o1) do { \
        __builtin_amdgcn_global_load_lds((const unsigned*)((const char*)(gbase) + (o0)), (LAS unsigned*)(lds + (bufoff) + ldsw), 16, 0, 0); \
        __builtin_amdgcn_global_load_lds((const unsigned*)((const char*)(gbase) + (o1)), (LAS unsigned*)(lds + (bufoff) + ldsw + 8192), 16, 0, 0); } while (0)
#define PG8_STA(bufoff, gbase, V, h) PG8_STAGE(bufoff, gbase, V[h][0], V[h][1])
#define PG8_LDA(dst, b, h) do { _Pragma("unroll") for (int m = 0; m < 4; ++m) _Pragma("unroll") for (int k = 0; k < 2; ++k) dst[m][k] = *(const LAS bf16x8*)(lds + PG8_SA(b, h) + aoff + m * 2048 + k * 1024); } while (0)
#define PG8_LDB(dst, b, h) do { _Pragma("unroll") for (int n = 0; n < 2; ++n) _Pragma("unroll") for (int k = 0; k < 2; ++k) dst[n][k] = *(const LAS bf16x8*)(lds + PG8_SB(b, h) + boff + n * 2048 + k * 1024); } while (0)
#define PG8_MMA(ai, bj, At, Bt) do { __builtin_amdgcn_s_setprio(1); _Pragma("unroll") for (int m = 0; m < 4; ++m) _Pragma("unroll") for (int n = 0; n < 2; ++n) _Pragma("unroll") for (int k = 0; k < 2; ++k) \
        acc[ai][bj][m][n] = __builtin_amdgcn_mfma_f32_16x16x32_bf16(Bt[n][k], At[m][k], acc[ai][bj][m][n], 0, 0, 0); __builtin_amdgcn_s_setprio(0); } while (0)
#define PG8_WAIT_V(n) asm volatile("s_waitcnt vmcnt(" #n ")" ::: "memory")
#define PG8_WAIT_L(n) asm volatile("s_waitcnt lgkmcnt(" #n ")" ::: "memory")
#define PG8_BAR __builtin_amdgcn_s_barrier()
#define PG8_SCHED __builtin_amdgcn_sched_barrier(0)
    f32x4 acc[2][2][4][2];
#pragma unroll
    for (int a = 0; a < 2; ++a)
#pragma unroll
        for (int b = 0; b < 2; ++b)
#pragma unroll
            for (int m = 0; m < 4; ++m)
#pragma unroll
                for (int n = 0; n < 2; ++n) acc[a][b][m][n] = (f32x4){0.f, 0.f, 0.f, 0.f};
    bf16x8 At[4][2], B0[2][2], B1[2][2];
    const char* cA = cur.a; const char* cB = cur.b;
    PG8_STA(PG8_SB(0, 0), cB, vB, 0); PG8_STA(PG8_SB(0, 1), cB, vB, 1); PG8_STA(PG8_SA(0, 0), cA, vA, 0); PG8_STA(PG8_SA(0, 1), cA, vA, 1);
    if (wr == 1) PG8_BAR;
    PG8_WAIT_V(2); PG8_BAR;
    PG8_STA(PG8_SB(1, 0), cB + kstep, vB, 0); PG8_STA(PG8_SA(1, 0), cA + kstep, vA, 0); PG8_STA(PG8_SB(1, 1), cB + kstep, vB, 1);
    PG8_WAIT_V(6); PG8_BAR;
    for (;;) {
        const bool has_next = S.next(ui + 1, nxt);
        const char* nA = has_next ? nxt.a : cA; const char* nB = has_next ? nxt.b : cB;
        if (Sched::GATHER) {
            if (has_next) {
#pragma unroll
                for (int i = 0; i < 2; ++i) { int t_ = tid; asm volatile("" : "+v"(t_)); int R_, C_; stage_rc(t_ * 16 + i * 8192, R_, C_);
#pragma unroll
                    for (int h = 0; h < 2; ++h) xoff[h * 2 + i] = S.offA(nxt, h, R_, C_); }
            }
        }
        for (int t = 0; t < nt; t += 2) {
            const bool last = (t == nt - 2);
            const char* a1 = cA + (size_t)(t + 1) * kstep;
            const char* a2 = last ? nA : cA + (size_t)(t + 2) * kstep; const char* b2 = last ? nB : cB + (size_t)(t + 2) * kstep;
            const char* a3 = a2 + kstep; const char* b3 = b2 + kstep;
            PG8_LDB(B0, 0, 0); PG8_LDB(B1, 0, 1); PG8_SCHED; PG8_LDA(At, 0, 0); PG8_STA(PG8_SA(1, 1), a1, vA, 1);
            PG8_WAIT_V(8); PG8_WAIT_L(0); PG8_BAR; PG8_MMA(0, 0, At, B0); PG8_MMA(0, 1, At, B1); PG8_BAR; PG8_SCHED;
            if (Sched::GATHER) { if (last && has_next) { vA[0][0] = xoff[0]; vA[0][1] = xoff[1]; vA[1][0] = xoff[2]; vA[1][1] = xoff[3]; } }
            PG8_LDA(At, 0, 1); PG8_STA(PG8_SB(0, 0), b2, vB, 0); PG8_STA(PG8_SB(0, 1), b2, vB, 1); PG8_STA(PG8_SA(0, 0), a2, vA, 0);
            PG8_WAIT_V(8); PG8_WAIT_L(0); PG8_BAR; PG8_MMA(1, 0, At, B0); PG8_MMA(1, 1, At, B1); PG8_BAR; PG8_SCHED;
            PG8_LDB(B0, 1, 0); PG8_LDB(B1, 1, 1); PG8_SCHED; PG8_LDA(At, 1, 0); PG8_STA(PG8_SA(0, 1), a2, vA, 1);
            PG8_WAIT_V(8); PG8_WAIT_L(0); PG8_BAR; PG8_MMA(0, 0, At, B0); PG8_MMA(0, 1, At, B1); PG8_BAR; PG8_SCHED;
            PG8_LDA(At, 1, 1); PG8_STA(PG8_SB(1, 0), b3, vB, 0); PG8_STA(PG8_SB(1, 1), b3, vB, 1); PG8_STA(PG8_SA(1, 0), a3, vA, 0);
            PG8_WAIT_V(8); PG8_WAIT_L(0); PG8_BAR; PG8_MMA(1, 0, At, B0); PG8_MMA(1, 1, At, B1); PG8_BAR; PG8_SCHED;
        }
        if constexpr (ALIGN_EPI) { if (wr == 0) PG8_BAR; }
        E(acc, cur, wr, wc, fr, fq);
        if (!has_next) break;
#pragma unroll
        for (int a = 0; a < 2; ++a)
#pragma unroll
            for (int b = 0; b < 2; ++b)
#pragma unroll
                for (int m = 0; m < 4; ++m)
#pragma unroll
                    for (int n = 0; n < 2; ++n) acc[a][b][m][n] = (f32x4){0.f, 0.f, 0.f, 0.f};
        cur = nxt; cA = nA; cB = nB; ++ui;
        if constexpr (ALIGN_EPI) { if (wr == 1) PG8_BAR; }
    }
    PG8_WAIT_V(0);
    if constexpr (!ALIGN_EPI) { if (wr == 0) PG8_BAR; }
    PG8_BAR;
#undef PG8_SA
#undef PG8_SB
#undef PG8_STAGE
#undef PG8_STA
#undef PG8_LDA
#undef PG8_LDB
#undef PG8_MMA
#undef PG8_WAIT_V
#undef PG8_WAIT_L
#undef PG8_BAR
#undef PG8_SCHED
}
}

constexpr int BATCH = 2, SEQ = 8192, DM = 1024, MTOK = BATCH * SEQ, INC = 3072;
constexpr int NEXP = 32, DEXP = 256, NWAVES = 8;
constexpr float EPS = 1e-6f, LOG2E = 1.4426950408889634f;
constexpr float LAMBDA_INIT = 0.2f;
constexpr int MAXTILES = 160, MAXSLOTS = MAXTILES * 256;

constexpr size_t MiB = 1u << 20;
constexpr size_t WS_CTL = 0, CTL_ZERO_BYTES = 64 * 1024;
constexpr size_t WS_MODV = 1 * MiB;
constexpr size_t WS_WR = 1 * MiB + 256 * 1024;
constexpr size_t WS_WIN = 2 * MiB;
constexpr size_t WS_WOUT = 8 * MiB;
constexpr size_t WS_W13 = 10 * MiB;
constexpr size_t WS_W2 = 42 * MiB;
constexpr size_t WS_HB = 58 * MiB;
constexpr size_t WS_QD = 90 * MiB, WS_KD = 106 * MiB, WS_VD = 122 * MiB, WS_QS = 138 * MiB, WS_KS = 154 * MiB, WS_VS = 170 * MiB;
constexpr size_t WS_AO = 186 * MiB;
constexpr size_t WS_ROUTE = 218 * MiB;
constexpr size_t WS_LIST = WS_ROUTE + 256 * 1024, WS_LISTW = WS_LIST + 2 * MiB;
constexpr size_t WS_HG = 90 * MiB;
constexpr size_t WS_Y = 110 * MiB;
constexpr size_t WS_END = 224 * MiB;
static_assert(WS_HG + (size_t)MAXSLOTS * 256 * 2 <= WS_Y && WS_Y + (size_t)MAXSLOTS * 1024 * 2 <= WS_ROUTE && WS_LISTW + 2 * MiB <= WS_END, "ws map");
constexpr int CW_CNT = 256;
constexpr int CW_QUEUE = 128;
constexpr int CW_BAR = 4096;

constexpr int RING_OFF = 0, RING_BYTES = 131072;
constexpr int LDSCTL_OFF = RING_BYTES, MISC_OFF = LDSCTL_OFF + 320;
constexpr int TPRE_OFF = LDSCTL_OFF + 1024;
constexpr int LDS_BYTES = 147456;

typedef GAS unsigned gu32;
#define RLX_AGENT __ATOMIC_RELAXED, __HIP_MEMORY_SCOPE_AGENT
#define LDS_WAIT() asm volatile("s_waitcnt lgkmcnt(0)" ::: "memory")
#define VM_WAIT() asm volatile("s_waitcnt vmcnt(0)" ::: "memory")

#define XB_TMO      128
#define XB_XCNT(j)  (256  + 64 * (j))
#define XB_XSUB(j)  (1280 + 64 * (j))
#define XB_XGEN(j)  (2304 + 64 * (j))
#define XB_TOP      3328
#define XB_TOPGEN   3392
#define XCD_BAR_WORDS 3456
#define XB_SPIN_CAP (1u << 20)
__device__ __forceinline__ unsigned xb_ld(unsigned* p)              { return __hip_atomic_load(p, __ATOMIC_RELAXED, __HIP_MEMORY_SCOPE_AGENT); }
__device__ __forceinline__ unsigned xb_add(unsigned* p, unsigned v) { return __hip_atomic_fetch_add(p, v, __ATOMIC_RELAXED, __HIP_MEMORY_SCOPE_AGENT); }
__device__ __forceinline__ unsigned xb_xcc_id() { return (unsigned)__builtin_amdgcn_s_getreg((3 << 11) | 20) & 0xFu; }
#define XB_SPIN(cond, bar) do { unsigned _sp = 0; while (cond) { __builtin_amdgcn_s_sleep(1); \
    if ((++_sp & 255u) == 0u) { if (xb_ld(&(bar)[XB_TMO])) break; if (_sp > XB_SPIN_CAP) { atomicAdd(&(bar)[XB_TMO], 1u); break; } } } } while (0)
struct XcdBarrier { unsigned* bar; unsigned x; volatile LAS unsigned* st; };
__device__ __forceinline__ XcdBarrier xcd_barrier_post(unsigned* bar, volatile LAS unsigned* st) {
    XcdBarrier b; b.bar = bar; b.x = xb_xcc_id(); b.st = st;
    if (threadIdx.x == 0) (void)xb_add(&bar[XB_XCNT(b.x)], 1u);
    return b;
}
__device__ __forceinline__ void xcd_barrier_complete(unsigned* bar, unsigned x, unsigned& nloc, unsigned& nx) {
    const unsigned G = gridDim.x * gridDim.y * gridDim.z;
    unsigned sum, cnt, mine, sp = 0u;
    for (;;) {
        sum = 0u; cnt = 0u; mine = 0u;
#pragma unroll
        for (unsigned j = 0; j < 16; ++j) { const unsigned c = xb_ld(&bar[XB_XCNT(j)]); sum += c; cnt += (c > 0u) ? 1u : 0u; mine = (j == x) ? c : mine; }
        if (sum == G) break;
        __builtin_amdgcn_s_sleep(1);
        if ((++sp & 255u) == 0u) { if (xb_ld(&bar[XB_TMO])) break; if (sp > XB_SPIN_CAP) { atomicAdd(&bar[XB_TMO], 1u); break; } }
    }
    nloc = mine > 0u ? mine : 1u; nx = cnt > 0u ? cnt : 1u;
}
__device__ __forceinline__ void xcd_barrier(const XcdBarrier& b) {
    asm volatile("s_waitcnt vmcnt(0)" ::: "memory");
    __syncthreads();
    if (threadIdx.x == 0) {
        unsigned* bar = b.bar;
        __builtin_amdgcn_s_waitcnt(0);
        unsigned nloc = b.st[0], nx = b.st[1];
        if (nloc == 0u) { xcd_barrier_complete(bar, b.x, nloc, nx); b.st[0] = nloc; b.st[1] = nx; }
        const unsigned old = xb_add(&bar[XB_XSUB(b.x)], 1u);
        const unsigned gen = old / nloc;
        if (old + 1u == (gen + 1u) * nloc) {
            __builtin_amdgcn_fence(__ATOMIC_RELEASE, "agent");
            asm volatile("s_waitcnt vmcnt(0)" ::: "memory");
            const unsigned og = xb_add(&bar[XB_TOP], 1u);
            const unsigned tg = og / nx;
            if (og + 1u == (tg + 1u) * nx) xb_add(&bar[XB_TOPGEN], 1u);
            else XB_SPIN(xb_ld(&bar[XB_TOPGEN]) == tg, bar);
            __builtin_amdgcn_fence(__ATOMIC_ACQUIRE, "agent");
            xb_add(&bar[XB_XGEN(b.x)], 1u);
            asm volatile("s_waitcnt vmcnt(0)" ::: "memory");
        } else {
            XB_SPIN(xb_ld(&bar[XB_XGEN(b.x)]) == gen, bar);
            __builtin_amdgcn_fence(__ATOMIC_ACQUIRE, "agent");
            asm volatile("s_waitcnt vmcnt(0)" ::: "memory");
        }
    }
    __syncthreads();
}

__device__ __forceinline__ float wave_sum(float v) {
#pragma unroll
    for (int o = 1; o < 64; o <<= 1) v += __shfl_xor(v, o);
    return v;
}
__device__ __forceinline__ float wave_max(float v) {
#pragma unroll
    for (int o = 1; o < 64; o <<= 1) v = fmaxf(v, __shfl_xor(v, o));
    return v;
}
__device__ __forceinline__ unsigned f2bf(float f) { unsigned u = __builtin_bit_cast(unsigned, f); return (u + 0x7fffu + ((u >> 16) & 1u)) >> 16; }
__device__ __forceinline__ unsigned pk2(float lo, float hi) { return f2bf(lo) | (f2bf(hi) << 16); }
__device__ __forceinline__ float bf2f(unsigned short h) { return __builtin_bit_cast(float, (unsigned)h << 16); }

struct DenseSched {
    static constexpr bool GATHER = false;
    int nM, nN, nwg, G, c, K; const char* A; const char* B; int bmode;
    bool perm;
    __device__ __forceinline__ bool next(int i, pg8::Unit& u) const {
        const long L = (long)i * G + c; if (L >= nwg) return false;
        int wgid = (int)L; { const int q = nwg / pg8::NXCD, r = nwg % pg8::NXCD, xcd = wgid % pg8::NXCD, off = wgid / pg8::NXCD; wgid = (xcd < r ? xcd * (q + 1) : r * (q + 1) + (xcd - r) * q) + off; }
        const int nig = pg8::WGM * nN, gid = wgid / nig, fm = gid * pg8::WGM, gsz = (nM - fm) < pg8::WGM ? (nM - fm) : pg8::WGM;
        u.pm = fm + ((wgid % nig) % gsz); u.pn = (wgid % nig) / gsz;
        u.a = A + (size_t)u.pm * 256 * K * 2; u.b = B + (size_t)u.pn * 256 * K * 2; u.e = 0; u.loc0 = 0; u.cnt = 0; u.pad = 0; return true;
    }
    __device__ __forceinline__ unsigned offA(const pg8::Unit&, int h, int R, int C) const { return (unsigned)((h * 128 + R) * K + C) * 2u; }
    __device__ __forceinline__ unsigned offB(int h, int R, int C) const {
        int row;
        if (bmode == 1) row = 64 * (R >> 5) + 32 * h + pg8::perm32(R & 31);
        else row = h * 128 + (perm ? ((R & ~31) + pg8::perm32(R & 31)) : R);
        return (unsigned)(row * K + C) * 2u;
    }
};

struct EpiQKV {
    bf16_t *Qd, *Kd, *Vd, *Qs, *Ks, *Vs; const float *gq, *gk;
    __device__ __forceinline__ void operator()(const f32x4 (&acc)[2][2][4][2], const pg8::Unit& u, int wr, int wc, int fr, int fq) const {
        asm volatile("" : "+v"(fr), "+v"(fq));
        const int pn = u.pn, sec = pn >> 1, G = 4 * (pn & 1) + wc;
        const int row0 = u.pm * 256 + wr * 64 + fr;
        const int b = row0 >> 13;
        float gv[2][2][4];
        if (sec < 2) { const float* g = sec == 0 ? gq : gk; const float sc = sec == 0 ? (0.125f * LOG2E) : 1.0f;
#pragma unroll
            for (int bj = 0; bj < 2; ++bj)
#pragma unroll
                for (int n = 0; n < 2; ++n) { const f32x4 t = *(const f32x4*)(g + 32 * bj + 8 * fq + 4 * n); gv[bj][n][0] = t[0] * sc; gv[bj][n][1] = t[1] * sc; gv[bj][n][2] = t[2] * sc; gv[bj][n][3] = t[3] * sc; }
        }
#pragma unroll
        for (int ai = 0; ai < 2; ++ai)
#pragma unroll
            for (int m = 0; m < 4; ++m) {
                const int row = row0 + ai * 128 + m * 16, s = row & (SEQ - 1);
                f32x4 v[2][2];
#pragma unroll
                for (int bj = 0; bj < 2; ++bj)
#pragma unroll
                    for (int n = 0; n < 2; ++n) v[bj][n] = acc[ai][bj][m][n];
                if (sec < 2) {
                    float ss = 0.f;
#pragma unroll
                    for (int bj = 0; bj < 2; ++bj)
#pragma unroll
                        for (int n = 0; n < 2; ++n) ss += (v[bj][n][0] * v[bj][n][0] + v[bj][n][1] * v[bj][n][1]) + (v[bj][n][2] * v[bj][n][2] + v[bj][n][3] * v[bj][n][3]);
                    ss += __shfl_xor(ss, 16); ss += __shfl_xor(ss, 32);
                    const float r = __builtin_amdgcn_rsqf(ss * (1.0f / 64.0f) + EPS);
#pragma unroll
                    for (int bj = 0; bj < 2; ++bj)
#pragma unroll
                        for (int n = 0; n < 2; ++n)
#pragma unroll
                            for (int i = 0; i < 4; ++i) v[bj][n][i] = v[bj][n][i] * r * gv[bj][n][i];
                } else if (sec == 3) {
#pragma unroll
                    for (int bj = 0; bj < 2; ++bj)
#pragma unroll
                        for (int n = 0; n < 2; ++n) v[bj][n] = v[bj][n] * (0.125f * LOG2E);
                }
#pragma unroll
                for (int bj = 0; bj < 2; ++bj) {
                    u32x4 w; w.x = cvtpk(v[bj][0][0], v[bj][0][1]); w.y = cvtpk(v[bj][0][2], v[bj][0][3]); w.z = cvtpk(v[bj][1][0], v[bj][1][1]); w.w = cvtpk(v[bj][1][2], v[bj][1][3]);
                    size_t off; bf16_t* base;
                    if (sec == 0 || sec == 3) {
                        base = sec == 0 ? Qd : Qs; off = ((size_t)(b * 8 + G) * SEQ + s) * 64 + 32 * bj + 8 * fq;
                    } else if (sec == 1 || sec == 4) {
                        base = sec == 1 ? Kd : Ks; off = ((((size_t)(b * 8 + G) * 128 + (s >> 6)) * 8 + 4 * bj + fq) * 64 + (s & 63)) * 8;
                    } else if (sec == 2) {
                        base = Vd; off = (((((size_t)(b * 4 + (G >> 1)) * 128 + (s >> 6)) * 4 + 2 * (G & 1) + bj) * 4 + ((s & 63) >> 4)) * 16 + (s & 15)) * 32 + 8 * fq;
                    } else {
                        base = Vs; off = (((((size_t)(b * 8 + G) * 128 + (s >> 6)) * 2 + bj) * 4 + ((s & 63) >> 4)) * 16 + (s & 15)) * 32 + 8 * fq;
                    }
                    *(u32x4*)(base + off) = w;
                }
            }
    }
};

struct EpiX1 {
    const float* x; float* out; const float* gt;
    __device__ __forceinline__ void operator()(const f32x4 (&acc)[2][2][4][2], const pg8::Unit& u, int wr, int wc, int fr, int fq) const {
        asm volatile("" : "+v"(fr), "+v"(fq));
        const int row0 = u.pm * 256 + wr * 64 + fr, b = row0 >> 13, col0 = u.pn * 256 + wc * 32 + 8 * fq;
        f32x4 g[2][2];
#pragma unroll
        for (int bj = 0; bj < 2; ++bj)
#pragma unroll
            for (int n = 0; n < 2; ++n) g[bj][n] = *(const f32x4*)(gt + (size_t)b * 6144 + col0 + bj * 128 + n * 4);
#pragma unroll
        for (int ai = 0; ai < 2; ++ai)
#pragma unroll
            for (int m = 0; m < 4; ++m) { const size_t off = (size_t)(row0 + ai * 128 + m * 16) * DM + col0;
                f32x4 xv[2][2];
#pragma unroll
                for (int bj = 0; bj < 2; ++bj)
#pragma unroll
                    for (int n = 0; n < 2; ++n) xv[bj][n] = *(const f32x4*)(x + off + bj * 128 + n * 4);
#pragma unroll
                for (int bj = 0; bj < 2; ++bj)
#pragma unroll
                    for (int n = 0; n < 2; ++n) *(f32x4*)(out + off + bj * 128 + n * 4) = xv[bj][n] + g[bj][n] * acc[ai][bj][m][n]; }
    }
};

struct MoeUpSched {
    static constexpr bool GATHER = true;
    int G, c; const LAS int* tpre; const LAS int* cnts; const int* list; const char* A; const char* B;
    __device__ __forceinline__ bool next(int i, pg8::Unit& u) const {
        const int L = i * G + c, T = tpre[32]; if (L >= 2 * T) return false;
        const int tau = L >> 1, pn = L & 1; int e = 0;
#pragma unroll 1
        for (int j = 1; j < 32; ++j) if (tpre[j] <= tau) e = j;
        u.pm = tau; u.pn = pn; u.e = e; u.loc0 = (tau - tpre[e]) * 256; u.cnt = cnts[e]; u.pad = 0;
        u.a = A; u.b = B + ((size_t)e * 512 + 128 * pn) * 1024 * 2; return true;
    }
    __device__ __forceinline__ unsigned offA(const pg8::Unit& u, int h, int R, int C) const {
        const int loc = u.loc0 + h * 128 + R; int tok = 0;
        if (loc < u.cnt) tok = list[u.e * MTOK + loc];
        return (unsigned)(tok * 1024 + C) * 2u;
    }
    __device__ __forceinline__ unsigned offB(int h, int R, int C) const { return (unsigned)((256 * h + (R & ~31) + pg8::perm32(R & 31)) * 1024 + C) * 2u; }
};
struct EpiAct {
    bf16_t* hg; const float* listw;
    __device__ __forceinline__ void operator()(const f32x4 (&acc)[2][2][4][2], const pg8::Unit& u, int wr, int wc, int fr, int fq) const {
        asm volatile("" : "+v"(fr), "+v"(fq));
        const int col0 = 128 * u.pn + 32 * wc + 8 * fq;
#pragma unroll
        for (int ai = 0; ai < 2; ++ai)
#pragma unroll
            for (int m = 0; m < 4; ++m) {
                const int rl = 128 * ai + 64 * wr + 16 * m + fr, loc = u.loc0 + rl;
                float w = 0.f; if (loc < u.cnt) w = listw[u.e * MTOK + loc];
                float o[8];
#pragma unroll
                for (int n = 0; n < 2; ++n)
#pragma unroll
                    for (int i = 0; i < 4; ++i) { const float a = acc[ai][0][m][n][i], g = acc[ai][1][m][n][i]; const float sg = a * __builtin_amdgcn_rcpf(1.0f + __builtin_amdgcn_exp2f(-a * LOG2E)); o[4 * n + i] = sg * g * w; }
                u32x4 q; q.x = cvtpk(o[0], o[1]); q.y = cvtpk(o[2], o[3]); q.z = cvtpk(o[4], o[5]); q.w = cvtpk(o[6], o[7]);
                *(u32x4*)(hg + ((size_t)u.pm * 256 + rl) * DEXP + col0) = q;
            }
    }
};
struct MoeDownSched {
    static constexpr bool GATHER = false;
    int G, c; const LAS int* tpre; const char* A; const char* B;
    __device__ __forceinline__ bool next(int i, pg8::Unit& u) const {
        const int L = i * G + c, T = tpre[32]; if (L >= 4 * T) return false;
        const int tau = L >> 2, pn = L & 3; int e = 0;
#pragma unroll 1
        for (int j = 1; j < 32; ++j) if (tpre[j] <= tau) e = j;
        u.pm = tau; u.pn = pn; u.e = e; u.loc0 = 0; u.cnt = 0; u.pad = 0;
        u.a = A + (size_t)tau * 256 * DEXP * 2; u.b = B + ((size_t)e * 1024 + 256 * pn) * DEXP * 2; return true;
    }
    __device__ __forceinline__ unsigned offA(const pg8::Unit&, int h, int R, int C) const { return (unsigned)((h * 128 + R) * DEXP + C) * 2u; }
    __device__ __forceinline__ unsigned offB(int h, int R, int C) const { return (unsigned)((h * 128 + (R & ~31) + pg8::perm32(R & 31)) * DEXP + C) * 2u; }
};
struct EpiY {
    bf16_t* y;
    __device__ __forceinline__ void operator()(const f32x4 (&acc)[2][2][4][2], const pg8::Unit& u, int wr, int wc, int fr, int fq) const {
        asm volatile("" : "+v"(fr), "+v"(fq));
        const int col0 = 256 * u.pn + 32 * wc + 8 * fq;
#pragma unroll
        for (int ai = 0; ai < 2; ++ai)
#pragma unroll
            for (int m = 0; m < 4; ++m) { bf16_t* rowp = y + ((size_t)u.pm * 256 + 128 * ai + 64 * wr + 16 * m + fr) * DM + col0;
#pragma unroll
                for (int bj = 0; bj < 2; ++bj) { const f32x4 v0 = acc[ai][bj][m][0], v1 = acc[ai][bj][m][1];
                    u32x4 w; w.x = cvtpk(v0[0], v0[1]); w.y = cvtpk(v0[2], v0[3]); w.z = cvtpk(v1[0], v1[1]); w.w = cvtpk(v1[2], v1[3]);
                    *(u32x4*)(rowp + bj * 128) = w; } }
    }
};

namespace att {
constexpr float ZTHR = 170.0f;
__device__ __forceinline__ int crow(int r, int hi) { return (r & 3) + 8 * (r >> 2) + 4 * hi; }
__device__ __forceinline__ s16x4 vtr(const LAS unsigned char* p) { return __builtin_bit_cast(s16x4, __builtin_amdgcn_ds_read_tr16_b64_v4i16((LAS s16x4*)p)); }
__device__ __forceinline__ bf16x8 cat8(s16x4 lo, s16x4 hi) { return (bf16x8){lo[0], lo[1], lo[2], lo[3], hi[0], hi[1], hi[2], hi[3]}; }
__device__ __forceinline__ float swap_add(float v) { auto rr = __builtin_amdgcn_permlane32_swap(__float_as_uint(v), __float_as_uint(v), false, false); return __uint_as_float(rr[0]) + __uint_as_float(rr[1]); }

struct AttnP {
    const bf16_t *Qd, *Kd, *Vd, *Qs, *Ks, *Vs; bf16_t* AO;
    const float *gq, *gk, *lq1, *lk1, *lq2, *lk2, *dog, *sog;
};

#define ATT_WAITBAR(N) asm volatile("s_waitcnt vmcnt(" #N ") lgkmcnt(0)\n\ts_barrier" ::: "memory")
#define GLDS16(src, dstoff) __builtin_amdgcn_global_load_lds((const unsigned*)(src), (LAS unsigned*)(lds + (dstoff) + ldsw), 16, 0, 0)
__device__ __forceinline__ void diff_unit(const AttnP& P, int b, int hh, int iq, LAS unsigned char* lds, float lam, float Mp) {
    int tid = threadIdx.x; asm volatile("" : "+v"(tid)); const int lane = tid & 63, r32 = lane & 31, hi = lane >> 5;
    const int wid = __builtin_amdgcn_readfirstlane(tid >> 6), mp = wid >> 2, rg = wid & 3;
    const int q0 = iq * 128, qw0 = q0 + 32 * rg, NT = 2 * (iq + 1);
    const int vh = 2 * hh + mp;
    const float slope = exp2f(-2.0f * (float)(hh + 1)) * LOG2E;
    const bf16_t* Qg = P.Qd + ((size_t)(b * 8 + vh) * SEQ + qw0 + r32) * 64;
    const unsigned char* K0g = (const unsigned char*)(P.Kd + (size_t)(b * 8 + 2 * hh) * SEQ * 64) + tid * 16;
    const unsigned char* K1g = (const unsigned char*)(P.Kd + (size_t)(b * 8 + 2 * hh + 1) * SEQ * 64) + tid * 16;
    const unsigned char* Vg = (const unsigned char*)(P.Vd + (size_t)(b * 4 + hh) * SEQ * 128) + tid * 16;
    bf16x8 qf[4];
#pragma unroll
    for (int s = 0; s < 4; ++s) qf[s] = *(const bf16x8*)(Qg + 16 * s + 8 * hi);
    const float lbase = slope * (float)(4 * hi - r32);
    f32x16 o[4];
#pragma unroll
    for (int d = 0; d < 4; ++d) o[d] = f32x16{};
    float lsum = 0.f;
    const unsigned ldsw = (unsigned)wid * 1024u;
#define DLOAD(j) do { const int so_ = ((j) & 3) * 32768; GLDS16(K0g + (size_t)(j) * 8192, so_); GLDS16(K1g + (size_t)(j) * 8192, so_ + 8192); \
        GLDS16(Vg + (size_t)(j) * 16384, so_ + 16384); GLDS16(Vg + (size_t)(j) * 16384 + 8192, so_ + 24576); } while (0)
#define DQK(P0, P1, j) do { const LAS unsigned char* Kb_ = lds + ((j) & 3) * 32768 + mp * 8192 + hi * 1024 + r32 * 16; \
        const float T0_ = -Mp - slope * (float)(qw0 - 64 * (j)) + lbase, T1_ = T0_ + 32.0f * slope; \
        _Pragma("unroll") for (int r = 0; r < 16; ++r) { const float cr = (float)((r & 3) + 8 * (r >> 2)); P0[r] = fmaf(slope, cr, T0_); P1[r] = fmaf(slope, cr, T1_); } \
        _Pragma("unroll") for (int s = 0; s < 4; ++s) { \
            const bf16x8 a0 = *(const LAS bf16x8*)(Kb_ + s * 2048), a1 = *(const LAS bf16x8*)(Kb_ + s * 2048 + 512); \
            P0 = __builtin_amdgcn_mfma_f32_32x32x16_bf16(a0, qf[s], P0, 0, 0, 0); \
            P1 = __builtin_amdgcn_mfma_f32_32x32x16_bf16(a1, qf[s], P1, 0, 0, 0); } } while (0)
    const int jlast = (qw0 + 31) >> 6;
    const float dwin = ZTHR / slope;
    const int jstart = max(0, (int)floorf(((float)q0 - dwin - 63.0f) * (1.0f / 64.0f)) + 1);
    const int jfirst = max(jstart, (int)floorf(((float)qw0 - dwin - 63.0f) * (1.0f / 64.0f)) + 1);
    DLOAD(jstart); if (jstart + 1 < NT) DLOAD(jstart + 1); if (jstart + 2 < NT) DLOAD(jstart + 2);
    if (jstart + 2 < NT) ATT_WAITBAR(8); else if (jstart + 1 < NT) ATT_WAITBAR(4); else ATT_WAITBAR(0);
    f32x16 p0, p1, n0, n1;
    if (jfirst == jstart) DQK(p0, p1, jstart);
    const int vlane = ((lane >> 4) & 1) * 32 + (lane & 3) * 8 + (4 * hi + ((lane & 15) >> 2)) * 64;
#define DBODY(DIAG, NEXT, j) do { \
        const LAS unsigned char* Vb = lds + ((j) & 3) * 32768 + 16384 + vlane; \
        if (NEXT) DQK(n0, n1, (j) + 1); \
        if (DIAG) { const int dq = qw0 + r32 - 64 * (j); \
            _Pragma("unroll") for (int r = 0; r < 16; ++r) { const int k0 = crow(r, hi); if (k0 > dq) p0[r] = -1e30f; if (k0 + 32 > dq) p1[r] = -1e30f; } } \
        _Pragma("unroll") for (int r = 0; r < 16; ++r) p0[r] = __builtin_amdgcn_exp2f(p0[r]); \
        float sa = 0.f; \
        _Pragma("unroll") for (int r = 0; r < 16; ++r) sa += p0[r]; \
        bf16x8 pf[2]; \
        _Pragma("unroll") for (int g = 0; g < 2; ++g) { u32x4 w; w.x = cvtpk(p0[8 * g + 0], p0[8 * g + 1]); w.y = cvtpk(p0[8 * g + 2], p0[8 * g + 3]); w.z = cvtpk(p0[8 * g + 4], p0[8 * g + 5]); w.w = cvtpk(p0[8 * g + 6], p0[8 * g + 7]); pf[g] = __builtin_bit_cast(bf16x8, w); } \
        _Pragma("unroll") for (int d = 0; d < 4; ++d) \
            _Pragma("unroll") for (int g = 0; g < 2; ++g) { const bf16x8 vf = cat8(vtr(Vb + d * 4096 + g * 1024), vtr(Vb + d * 4096 + g * 1024 + 512)); o[d] = __builtin_amdgcn_mfma_f32_32x32x16_bf16(vf, pf[g], o[d], 0, 0, 0); } \
        _Pragma("unroll") for (int r = 0; r < 16; ++r) p1[r] = __builtin_amdgcn_exp2f(p1[r]); \
        float sb = 0.f; \
        _Pragma("unroll") for (int r = 0; r < 16; ++r) sb += p1[r]; \
        lsum += sa + sb; \
        _Pragma("unroll") for (int g = 0; g < 2; ++g) { u32x4 w; w.x = cvtpk(p1[8 * g + 0], p1[8 * g + 1]); w.y = cvtpk(p1[8 * g + 2], p1[8 * g + 3]); w.z = cvtpk(p1[8 * g + 4], p1[8 * g + 5]); w.w = cvtpk(p1[8 * g + 6], p1[8 * g + 7]); pf[g] = __builtin_bit_cast(bf16x8, w); } \
        _Pragma("unroll") for (int d = 0; d < 4; ++d) \
            _Pragma("unroll") for (int g = 0; g < 2; ++g) { const bf16x8 vf = cat8(vtr(Vb + d * 4096 + (g + 2) * 1024), vtr(Vb + d * 4096 + (g + 2) * 1024 + 512)); o[d] = __builtin_amdgcn_mfma_f32_32x32x16_bf16(vf, pf[g], o[d], 0, 0, 0); } \
        if (NEXT) { p0 = n0; p1 = n1; } } while (0)
#define DTOP(j) do { if ((j) + 2 < NT) ATT_WAITBAR(4); else ATT_WAITBAR(0); if ((j) + 3 < NT) DLOAD((j) + 3); } while (0)
    int j = jstart;
    for (; j < jfirst; ++j) { DTOP(j); if (j + 1 == jfirst) DQK(p0, p1, j + 1); }
    for (; j < jlast; ++j) { DTOP(j); DBODY(false, true, j); }
    { DTOP(j); DBODY(true, false, j); ++j; }
    for (; j < NT; ++j) { DTOP(j); }
#undef DBODY
#undef DTOP
#undef DLOAD
#undef DQK
    ATT_WAITBAR(0);
    lsum = swap_add(lsum);
    const float inv = 1.0f / lsum;
    LAS float* exch = (LAS float*)lds + rg * 4096;
    if (mp == 1) {
#pragma unroll
        for (int d = 0; d < 4; ++d)
#pragma unroll
            for (int r = 0; r < 16; ++r) exch[(32 * d + crow(r, hi)) * 32 + r32] = o[d][r] * inv;
    }
    __syncthreads();
    if (mp == 0) {
        float ss = 0.f;
#pragma unroll
        for (int d = 0; d < 4; ++d)
#pragma unroll
            for (int r = 0; r < 16; ++r) { const float v = o[d][r] * inv - lam * exch[(32 * d + crow(r, hi)) * 32 + r32]; o[d][r] = v; ss += v * v; }
        ss = swap_add(ss);
        const float rr = __builtin_amdgcn_rsqf(ss * (1.0f / 128.0f) + EPS) * (1.0f - LAMBDA_INIT);
        LAS unsigned char* stg = lds + 65536 + rg * 8704;
#pragma unroll
        for (int d = 0; d < 4; ++d)
#pragma unroll
            for (int r = 0; r < 16; r += 2) { const int dd = 32 * d + crow(r, hi);
                *(LAS unsigned*)(stg + r32 * 272 + dd * 2) = cvtpk(o[d][r] * rr * P.dog[dd], o[d][r + 1] * rr * P.dog[dd + 1]); }
        LDS_WAIT();
        bf16_t* Og = P.AO + ((size_t)(b * SEQ) + qw0) * DM + 128 * hh;
#pragma unroll
        for (int it = 0; it < 8; ++it) { const int idx = it * 64 + lane, row = idx >> 4, ch = idx & 15;
            const u32x4 v = *(const LAS u32x4*)(stg + row * 272 + ch * 16); *(u32x4*)(Og + (size_t)row * DM + ch * 8) = v; }
    }
    __syncthreads();
}

__device__ __forceinline__ void sb_unit(const AttnP& P, int b, int h, int qb, LAS unsigned char* lds) {
    int tid = threadIdx.x; asm volatile("" : "+v"(tid)); const int lane = tid & 63, r32 = lane & 31, hi = lane >> 5;
    const int wid = __builtin_amdgcn_readfirstlane(tid >> 6);
    const int q0 = qb * 256, qw0 = q0 + 32 * wid, NT = 4 * (qb + 1);
    const bf16_t* Qg = P.Qs + ((size_t)(b * 8 + h) * SEQ + qw0 + r32) * 64;
    const unsigned char* Kg = (const unsigned char*)(P.Ks + (size_t)(b * 8 + h) * SEQ * 64) + tid * 16;
    const unsigned char* Vg = (const unsigned char*)(P.Vs + (size_t)(b * 8 + h) * SEQ * 64) + tid * 16;
    bf16x8 qf[4];
#pragma unroll
    for (int s = 0; s < 4; ++s) qf[s] = *(const bf16x8*)(Qg + 16 * s + 8 * hi);
    f16x8 atri[2], aone;
#pragma unroll
    for (int st = 0; st < 2; ++st)
#pragma unroll
        for (int jj = 0; jj < 8; ++jj) { const int j = 16 * st + 8 * (jj >> 2) + 4 * hi + (jj & 3); atri[st][jj] = (j >= r32) ? (_Float16)(-1.0f) : (_Float16)0.0f; }
#pragma unroll
    for (int jj = 0; jj < 8; ++jj) aone[jj] = (_Float16)(-1.0f);
    f32x16 o[2]; o[0] = f32x16{}; o[1] = f32x16{};
    f32x16 carry = f32x16{};
    const unsigned ldsw = (unsigned)wid * 1024u;
#define SLOAD(t) do { const int so_ = ((t) & 3) * 16384; const size_t go_ = (size_t)(NT - 1 - (t)) * 8192; GLDS16(Kg + go_, so_); GLDS16(Vg + go_, so_ + 8192); } while (0)
#define SQK(Z0, Z1, t) do { const LAS unsigned char* Kb_ = lds + ((t) & 3) * 16384 + hi * 1024 + r32 * 16; Z0 = f32x16{}; Z1 = f32x16{}; \
        _Pragma("unroll") for (int s = 0; s < 4; ++s) { \
            const bf16x8 a0 = *(const LAS bf16x8*)(Kb_ + s * 2048), a1 = *(const LAS bf16x8*)(Kb_ + s * 2048 + 512); \
            Z0 = __builtin_amdgcn_mfma_f32_32x32x16_bf16(a0, qf[s], Z0, 0, 0, 0); \
            Z1 = __builtin_amdgcn_mfma_f32_32x32x16_bf16(a1, qf[s], Z1, 0, 0, 0); } } while (0)
    const int jlast = (qw0 + 31) >> 6, tfirst = NT - 1 - jlast;
    LAS unsigned* ndone = (LAS unsigned*)(lds + 131072 + 512);
    if (tid == 0) *ndone = 0u;
    SLOAD(0); SLOAD(1); SLOAD(2);
    ATT_WAITBAR(4);
    f32x16 z0, z1, y0, y1;
    if (tfirst == 0) SQK(z0, z1, 0);
    const int vlane = ((lane >> 4) & 1) * 32 + (lane & 3) * 8 + (4 * hi + ((lane & 15) >> 2)) * 64;
#define SCAN(W, INC) do { f16x8 x0_, x1_; \
            _Pragma("unroll") for (int q = 0; q < 4; ++q) { const f16x2 t0_ = __builtin_bit_cast(f16x2, __builtin_amdgcn_cvt_pkrtz(W[2 * q], W[2 * q + 1])); x0_[2 * q] = t0_[0]; x0_[2 * q + 1] = t0_[1]; \
                const f16x2 t1_ = __builtin_bit_cast(f16x2, __builtin_amdgcn_cvt_pkrtz(W[8 + 2 * q], W[8 + 2 * q + 1])); x1_[2 * q] = t1_[0]; x1_[2 * q + 1] = t1_[1]; } \
            INC = __builtin_amdgcn_mfma_f32_32x32x16_f16(atri[0], x0_, carry, 0, 0, 0); \
            INC = __builtin_amdgcn_mfma_f32_32x32x16_f16(atri[1], x1_, INC, 0, 0, 0); \
            carry = __builtin_amdgcn_mfma_f32_32x32x16_f16(aone, x0_, carry, 0, 0, 0); \
            carry = __builtin_amdgcn_mfma_f32_32x32x16_f16(aone, x1_, carry, 0, 0, 0); } while (0)
#define SPV(A, BLK) do { _Pragma("unroll") for (int sp = 0; sp < 2; ++sp) { \
                u32x4 pw_; pw_.x = cvtpk(A[8 * sp + 0], A[8 * sp + 1]); pw_.y = cvtpk(A[8 * sp + 2], A[8 * sp + 3]); pw_.z = cvtpk(A[8 * sp + 4], A[8 * sp + 5]); pw_.w = cvtpk(A[8 * sp + 6], A[8 * sp + 7]); \
                const bf16x8 pf_ = __builtin_bit_cast(bf16x8, pw_); const int g_ = 2 * (BLK) + sp; \
                _Pragma("unroll") for (int d = 0; d < 2; ++d) { const bf16x8 vf_ = cat8(vtr(Vb + d * 4096 + g_ * 1024), vtr(Vb + d * 4096 + g_ * 1024 + 512)); \
                    o[d] = __builtin_amdgcn_mfma_f32_32x32x16_bf16(vf_, pf_, o[d], 0, 0, 0); } } } while (0)
#define SBODY(DIAG, NEXT, t) do { \
        const LAS unsigned char* Vb = lds + ((t) & 3) * 16384 + 8192 + vlane; \
        const int dq = qw0 + r32 - 64 * (NT - 1 - (t)); \
        if (NEXT) SQK(y0, y1, (t) + 1); \
        f32x16 w1_, w0_; \
        _Pragma("unroll") for (int r = 0; r < 16; ++r) { w1_[r] = __builtin_amdgcn_logf(1.0f + __builtin_amdgcn_exp2f(z1[r])); } \
        _Pragma("unroll") for (int r = 0; r < 16; ++r) { w0_[r] = __builtin_amdgcn_logf(1.0f + __builtin_amdgcn_exp2f(z0[r])); } \
        if (DIAG) { _Pragma("unroll") for (int r = 0; r < 16; ++r) { if (crow(r, hi) + 32 >= dq) w1_[r] = 0.f; if (crow(r, hi) >= dq) w0_[r] = 0.f; } } \
        f32x16 i1_, i0_; \
        SCAN(w1_, i1_); \
        SCAN(w0_, i0_); \
        _Pragma("unroll") for (int r = 0; r < 16; ++r) w1_[r] = __builtin_amdgcn_exp2f(z1[r] + i1_[r]); \
        if (DIAG) { _Pragma("unroll") for (int r = 0; r < 16; ++r) if (crow(r, hi) + 32 >= dq) w1_[r] = 0.f; } \
        SPV(w1_, 1); \
        _Pragma("unroll") for (int r = 0; r < 16; ++r) w0_[r] = __builtin_amdgcn_exp2f(z0[r] + i0_[r]); \
        if (DIAG) { _Pragma("unroll") for (int r = 0; r < 16; ++r) if (crow(r, hi) >= dq) w0_[r] = 0.f; } \
        SPV(w0_, 0); \
        if (NEXT) { z0 = y0; z1 = y1; } } while (0)
#define STOP(t) do { if ((t) + 2 < NT) ATT_WAITBAR(2); else ATT_WAITBAR(0); if ((t) + 3 < NT) SLOAD((t) + 3); } while (0)
    int t = 0; bool mydone = false;
    for (; t < tfirst; ++t) { STOP(t); if (t + 1 == tfirst) SQK(z0, z1, t + 1); }
    if (t + 1 < NT) { STOP(t); SBODY(true, true, t); ++t; mydone = __all(carry[0] <= -ZTHR);
        for (; t + 1 < NT && !mydone; ++t) { STOP(t); SBODY(false, true, t); mydone = __all(carry[0] <= -ZTHR); }
        if (!mydone) { STOP(t); SBODY(false, false, t); ++t; } }
    else { STOP(t); SBODY(true, false, t); ++t; }
    if (lane == 0) __hip_atomic_fetch_add(ndone, 1u, __ATOMIC_RELAXED, __HIP_MEMORY_SCOPE_WORKGROUP);
    for (; t < NT; ++t) { STOP(t); if (*(volatile LAS unsigned*)ndone == 8u) break; }
#undef SBODY
#undef STOP
#undef SCAN
#undef SPV
#undef SLOAD
#undef SQK
    ATT_WAITBAR(0);
    float ss = 0.f;
#pragma unroll
    for (int d = 0; d < 2; ++d)
#pragma unroll
        for (int r = 0; r < 16; ++r) ss += o[d][r] * o[d][r];
    ss = swap_add(ss);
    const float rr = __builtin_amdgcn_rsqf(ss * (1.0f / 64.0f) + EPS);
    LAS unsigned char* stg = lds + 65536 + wid * 4608;
#pragma unroll
    for (int d = 0; d < 2; ++d)
#pragma unroll
        for (int r = 0; r < 16; r += 2) { const int dd = 32 * d + crow(r, hi);
            *(LAS unsigned*)(stg + r32 * 144 + dd * 2) = cvtpk(o[d][r] * rr * P.sog[dd], o[d][r + 1] * rr * P.sog[dd + 1]); }
    LDS_WAIT();
    bf16_t* Og = P.AO + ((size_t)(b * SEQ) + qw0) * DM + 512 + 64 * h;
#pragma unroll
    for (int it = 0; it < 4; ++it) { const int idx = it * 64 + lane, row = idx >> 3, ch = idx & 7;
        const u32x4 v = *(const LAS u32x4*)(stg + row * 144 + ch * 16); *(u32x4*)(Og + (size_t)row * DM + ch * 8) = v; }
    __syncthreads();
}
#undef GLDS16
#undef ATT_WAITBAR
}

#ifndef MK_N_LAUNCHES
#define MK_N_LAUNCHES 1
#endif
constexpr int N_PHASES = 9;
struct Args { const float* in[23]; float* out; unsigned char* ws; int ph_lo, ph_hi; };

__device__ __forceinline__ void p0_transpose_item(const float* W, int K, int N, bf16_t* WT, int row_off, LAS float* scr, int item, int lane) {
    const int nblk = N / 32, kb = item / nblk, nb = item % nblk, k0 = 64 * kb, n0 = 32 * nb;
#pragma unroll 8
    for (int i = 0; i < 32; ++i) { const int kk = 2 * i + (lane >> 5); scr[kk * 33 + (lane & 31)] = W[(size_t)(k0 + kk) * N + n0 + (lane & 31)]; }
    LDS_WAIT(); asm volatile("" ::: "memory");
    const int c = lane & 7;
#pragma unroll
    for (int j = 0; j < 4; ++j) { const int n = (lane >> 3) + 8 * j; const LAS float* s = scr + (8 * c) * 33 + n;
        u32x4 o; o.x = pk2(s[0 * 33], s[1 * 33]); o.y = pk2(s[2 * 33], s[3 * 33]); o.z = pk2(s[4 * 33], s[5 * 33]); o.w = pk2(s[6 * 33], s[7 * 33]);
        *(u32x4*)(WT + (size_t)(row_off + n0 + n) * K + k0 + 8 * c) = o; }
    LDS_WAIT(); asm volatile("" ::: "memory");
}

__global__ void __launch_bounds__(NWAVES * 64, 2) mega_fwd(Args args) {
    extern __shared__ __attribute__((aligned(16))) unsigned char lds_raw[];
    LAS unsigned char* lds = (LAS unsigned char*)lds_raw;
    volatile LAS unsigned* MISC = (volatile LAS unsigned*)(lds + MISC_OFF);
    const int G = gridDim.x; const int bx = blockIdx.x;
#define PHASE_IDS() int tid = threadIdx.x; asm volatile("" : "+v"(tid)); const int lane = tid & 63, wave = __builtin_amdgcn_readfirstlane(tid >> 6); const int gw = vcu * NWAVES + wave, NGW = G * NWAVES; (void)lane; (void)gw; (void)NGW
    const int vcu = (G % 8 == 0) ? (bx % 8) * (G / 8) + bx / 8 : bx;
    unsigned char* ws = args.ws;
    unsigned* ctl = (unsigned*)(ws + WS_CTL);
    float* modv = (float*)(ws + WS_MODV);
    bf16_t* Wr_t = (bf16_t*)(ws + WS_WR); bf16_t* Win_t = (bf16_t*)(ws + WS_WIN); bf16_t* Wout_t = (bf16_t*)(ws + WS_WOUT);
    bf16_t* W13_t = (bf16_t*)(ws + WS_W13); bf16_t* W2_t = (bf16_t*)(ws + WS_W2); bf16_t* HB = (bf16_t*)(ws + WS_HB);
    bf16_t* AO = (bf16_t*)(ws + WS_AO); bf16_t* HG = (bf16_t*)(ws + WS_HG); bf16_t* Y = (bf16_t*)(ws + WS_Y);
    int* tokinfo = (int*)(ws + WS_ROUTE); int* list = (int*)(ws + WS_LIST); float* listw = (float*)(ws + WS_LISTW);
    const float* x = args.in[0]; float* out = args.out;

    for (int u = threadIdx.x; u < (LDS_BYTES - LDSCTL_OFF) / 4; u += NWAVES * 64) ((LAS unsigned*)(lds + LDSCTL_OFF))[u] = 0u;
    __syncthreads();
    XcdBarrier bar; bar.bar = ctl + CW_BAR; bar.x = 0; bar.st = nullptr;
    if (MK_N_LAUNCHES == 1) bar = xcd_barrier_post(ctl + CW_BAR, MISC + 8);
#ifdef TS_MASK
    LAS unsigned long long* tsb = (LAS unsigned long long*)(lds + LDSCTL_OFF + 12288);
    int tsn = 0;
#define TS_EV() do { if (blockIdx.x == 0 && threadIdx.x == 0) tsb[tsn] = __builtin_amdgcn_s_memrealtime(); ++tsn; } while (0)
#else
#define TS_EV() do {} while (0)
#endif
#define GRID_BAR() do { TS_EV(); if (MK_N_LAUNCHES == 1) xcd_barrier(bar); TS_EV(); } while (0)
    TS_EV();
    const int lo = args.ph_lo, hi = args.ph_hi;
#ifndef PHMASK
#define PHMASK 0x1ff
#endif
#define IN(k) ((((PHMASK) >> (k)) & 1) && lo <= (k) && (k) < hi)
#define BOTH(k) (IN(k) && IN((k) + 1))

#ifndef REP_P0
#define REP_P0 1
#endif
    for (int rep0 = 0; rep0 < REP_P0; ++rep0)
    if (IN(0)) {
        PHASE_IDS();
        for (int item = vcu; item < 192; item += G) {
            LAS float* sl = (LAS float*)lds;
            LAS float* red = (LAS float*)(lds + 8192);
            for (int i = tid; i < 2048; i += 512) { const float c = args.in[1][i]; sl[i] = c / (1.0f + __expf(-c)); }
            __syncthreads();
            const int n0 = 32 * item, col = lane & 31, kh = lane >> 5;
            const float* W = args.in[2] + n0 + col;
            float a0 = 0.f, a1 = 0.f;
#pragma unroll 16
            for (int i = 0; i < 64; ++i) { const int k = 128 * wave + 2 * i + kh; const float w = W[(size_t)k * 6144]; a0 += sl[k] * w; a1 += sl[1024 + k] * w; }
            a0 += __shfl_xor(a0, 32); a1 += __shfl_xor(a1, 32);
            if (lane < 32) { red[(wave * 2 + 0) * 32 + col] = a0; red[(wave * 2 + 1) * 32 + col] = a1; }
            __syncthreads();
            if (tid < 64) { const int b = tid >> 5, c2 = tid & 31; float v = 0.f;
#pragma unroll
                for (int w = 0; w < 8; ++w) v += red[(w * 2 + b) * 32 + c2];
                const int n = n0 + c2, j = n >> 10, k = n & 1023; v += args.in[3][n];
                if (j == 1) v = args.in[4][k] * (1.0f + v);
                if (j == 4) v = args.in[15][k] * (1.0f + v);
                modv[(b * 6 + j) * 1024 + k] = v; }
            __syncthreads();
        }
        if (vcu == G - 1) {
            for (int idx = tid; idx < 65536; idx += 512) { const int j = idx >> 10, k = idx & 1023; float v = 0.f;
                if (j < 4) v = args.in[16][k * 4 + j]; else if (j < 36) v = args.in[18][(size_t)((j - 4) >> 3) * 8192 + k * 8 + ((j - 4) & 7)];
                Wr_t[idx] = (bf16_t)f2bf(v); }
        }
        LAS float* scr = (LAS float*)(lds + wave * 16384);
        constexpr int I_IN = 16 * 96, I_OUT = 16 * 32, I_E = 128, NITEMS = I_IN + I_OUT + 3 * 32 * I_E;
        for (int it = gw; it < NITEMS; it += NGW) {
            int r = it;
            if (r < I_IN) { p0_transpose_item(args.in[5], 1024, 3072, Win_t, 0, scr, r, lane); continue; } r -= I_IN;
            if (r < I_OUT) { p0_transpose_item(args.in[14], 1024, 1024, Wout_t, 0, scr, r, lane); continue; } r -= I_OUT;
            if (r < 32 * I_E) { const int e = r / I_E; p0_transpose_item(args.in[20] + (size_t)e * 1024 * 256, 1024, 256, W13_t + (size_t)e * 512 * 1024, 0, scr, r % I_E, lane); continue; } r -= 32 * I_E;
            if (r < 32 * I_E) { const int e = r / I_E; p0_transpose_item(args.in[21] + (size_t)e * 1024 * 256, 1024, 256, W13_t + (size_t)e * 512 * 1024, 256, scr, r % I_E, lane); continue; } r -= 32 * I_E;
            { const int e = r / I_E; p0_transpose_item(args.in[22] + (size_t)e * 256 * 1024, 256, 1024, W2_t + (size_t)e * 1024 * 256, 0, scr, r % I_E, lane); }
        }
        if (BOTH(0)) GRID_BAR();
    }

#ifndef REP_P1
#define REP_P1 1
#endif
    for (int rep1 = 0; rep1 < REP_P1; ++rep1)
    if (IN(1)) {
        PHASE_IDS();
        for (int m0 = gw; m0 < MTOK; m0 += 2 * NGW) {
            const int m1 = m0 + NGW; const bool two = m1 < MTOK; const int mb = two ? m1 : m0;
            const f32x4* xa = (const f32x4*)(x + (size_t)m0 * DM) + lane; const f32x4* xb = (const f32x4*)(x + (size_t)mb * DM) + lane;
            f32x4 va[4], vb[4]; float sa = 0.f, sb = 0.f;
#pragma unroll
            for (int j = 0; j < 4; ++j) { va[j] = xa[64 * j]; vb[j] = xb[64 * j]; }
#pragma unroll
            for (int j = 0; j < 4; ++j) { sa += (va[j].x * va[j].x + va[j].y * va[j].y) + (va[j].z * va[j].z + va[j].w * va[j].w); sb += (vb[j].x * vb[j].x + vb[j].y * vb[j].y) + (vb[j].z * vb[j].z + vb[j].w * vb[j].w); }
#pragma unroll
            for (int o = 1; o < 64; o <<= 1) { sa += __shfl_xor(sa, o); sb += __shfl_xor(sb, o); }
            const float ra = __builtin_amdgcn_rsqf(sa * (1.f / DM) + EPS), rb = __builtin_amdgcn_rsqf(sb * (1.f / DM) + EPS);
            const int ba = m0 >> 13, bb = mb >> 13;
            const f32x4* gma = (const f32x4*)(modv + (ba * 6 + 1) * 1024) + lane; const f32x4* sha = (const f32x4*)(modv + (ba * 6 + 0) * 1024) + lane;
            const f32x4* gmb = (const f32x4*)(modv + (bb * 6 + 1) * 1024) + lane; const f32x4* shb = (const f32x4*)(modv + (bb * 6 + 0) * 1024) + lane;
            unsigned long long* oa = (unsigned long long*)(HB + (size_t)m0 * DM) + lane; unsigned long long* ob = (unsigned long long*)(HB + (size_t)mb * DM) + lane;
#pragma unroll
            for (int j = 0; j < 4; ++j) { const f32x4 ha = va[j] * ra * gma[64 * j] + sha[64 * j];
                oa[64 * j] = (unsigned long long)cvtpk(ha.x, ha.y) | ((unsigned long long)cvtpk(ha.z, ha.w) << 32); }
            if (two) {
#pragma unroll
                for (int j = 0; j < 4; ++j) { const f32x4 hb = vb[j] * rb * gmb[64 * j] + shb[64 * j];
                    ob[64 * j] = (unsigned long long)cvtpk(hb.x, hb.y) | ((unsigned long long)cvtpk(hb.z, hb.w) << 32); } }
        }
        if (BOTH(1)) GRID_BAR();
    }

#ifndef REP_P2
#define REP_P2 1
#endif
    for (int rep2 = 0; rep2 < REP_P2; ++rep2)
    if (IN(2)) {
        DenseSched S; S.nM = MTOK / 256; S.nN = INC / 256; S.nwg = S.nM * S.nN; S.G = G; S.c = bx; S.K = DM; S.A = (const char*)HB; S.B = (const char*)Win_t; S.bmode = 1; S.perm = true;
        EpiQKV E{(bf16_t*)(ws + WS_QD), (bf16_t*)(ws + WS_KD), (bf16_t*)(ws + WS_VD), (bf16_t*)(ws + WS_QS), (bf16_t*)(ws + WS_KS), (bf16_t*)(ws + WS_VS), args.in[6], args.in[7]};
        pg8::gemm_phase<EpiQKV, DenseSched, true>(lds + RING_OFF, DM, S, E);
        if (BOTH(2)) GRID_BAR();
    }

    if (IN(3)) {
        PHASE_IDS();
        att::AttnP P{(const bf16_t*)(ws + WS_QD), (const bf16_t*)(ws + WS_KD), (const bf16_t*)(ws + WS_VD), (const bf16_t*)(ws + WS_QS), (const bf16_t*)(ws + WS_KS), (const bf16_t*)(ws + WS_VS), AO,
                     args.in[6], args.in[7], args.in[8], args.in[9], args.in[10], args.in[11], args.in[12], args.in[13]};
        const float e1 = wave_sum(P.lq1[lane] * P.lk1[lane]), e2 = wave_sum(P.lq2[lane] * P.lk2[lane]);
        const float lam = __expf(e1) - __expf(e2) + LAMBDA_INIT;
        const float Mp = 8.0f * wave_max(fabsf(P.gq[lane])) * wave_max(fabsf(P.gk[lane])) * LOG2E;
        LAS unsigned* qslot = (LAS unsigned*)(lds + LDSCTL_OFF + 516);
#ifndef REP_ATT
#define REP_ATT 1
#endif
        for (int rep = 0; rep < REP_ATT; ++rep)
        for (;;) {
            if (tid == 0) *qslot = atomicAdd(ctl + CW_QUEUE + rep, 1u);
            __syncthreads();
            const int u = (int)*(volatile LAS unsigned*)qslot;
            if (u >= 1024) break;
            if (u < 512) { const int g2 = u >> 8, r = u & 255, iq = 63 - (r >> 2), hs = (r >> 1) & 1, b = r & 1, hh = g2 == 0 ? 3 - hs : 1 - hs; att::diff_unit(P, b, hh, iq, lds, lam, Mp); }
            else { const int s = u - 512, qb = 31 - (s >> 4), bh = s & 15; att::sb_unit(P, bh >> 3, bh & 7, qb, lds); }
        }
        if (BOTH(3)) GRID_BAR();
    }

#ifndef REP_P4
#define REP_P4 1
#endif
    for (int rep4 = 0; rep4 < REP_P4; ++rep4)
    if (IN(4)) {
        DenseSched S; S.nM = MTOK / 256; S.nN = DM / 256; S.nwg = S.nM * S.nN; S.G = G; S.c = bx; S.K = DM; S.A = (const char*)AO; S.B = (const char*)Wout_t; S.bmode = 0; S.perm = true;
        EpiX1 E{x, out, modv + 2 * 1024};
        pg8::gemm_phase<EpiX1, DenseSched, false>(lds + RING_OFF, DM, S, E);
        if (BOTH(4)) GRID_BAR();
    }

    if (IN(5)) {
        PHASE_IDS();
        LAS unsigned char* At = lds;
        LAS float* red = (LAS float*)(lds + 66560);
        for (int T = vcu; T < MTOK / 32; T += G) {
            const int row0 = T * 32, b = row0 >> 13;
            {
                const f32x4* gm = (const f32x4*)(modv + (b * 6 + 4) * 1024) + lane; const f32x4* sh = (const f32x4*)(modv + (b * 6 + 3) * 1024) + lane;
                f32x4 v[4][4]; float s[4];
#pragma unroll
                for (int rr = 0; rr < 4; ++rr) { const f32x4* xr = (const f32x4*)(out + (size_t)(row0 + 4 * wave + rr) * DM) + lane;
#pragma unroll
                    for (int j = 0; j < 4; ++j) v[rr][j] = xr[64 * j]; }
                f32x4 g[4], t[4];
#pragma unroll
                for (int j = 0; j < 4; ++j) { g[j] = gm[64 * j]; t[j] = sh[64 * j]; }
#pragma unroll
                for (int rr = 0; rr < 4; ++rr) { s[rr] = 0.f;
#pragma unroll
                    for (int j = 0; j < 4; ++j) s[rr] += (v[rr][j].x * v[rr][j].x + v[rr][j].y * v[rr][j].y) + (v[rr][j].z * v[rr][j].z + v[rr][j].w * v[rr][j].w); }
#pragma unroll
                for (int o = 1; o < 64; o <<= 1) {
#pragma unroll
                    for (int rr = 0; rr < 4; ++rr) s[rr] += __shfl_xor(s[rr], o); }
#pragma unroll
                for (int rr = 0; rr < 4; ++rr) { const int rl = 4 * wave + rr, m = row0 + rl; const float rstd = __builtin_amdgcn_rsqf(s[rr] * (1.f / DM) + EPS);
                    unsigned long long* o8 = (unsigned long long*)(HB + (size_t)m * DM) + lane;
#pragma unroll
                    for (int j = 0; j < 4; ++j) { const f32x4 hq = v[rr][j] * rstd * g[j] + t[j];
                        const unsigned long long pk = (unsigned long long)cvtpk(hq.x, hq.y) | ((unsigned long long)cvtpk(hq.z, hq.w) << 32);
                        o8[64 * j] = pk; *(LAS unsigned long long*)(At + rl * 2064 + (4 * lane + 256 * j) * 2) = pk; } }
            }
            __syncthreads();
            {
                f32x4 acc[2][3];
#pragma unroll
                for (int mf = 0; mf < 2; ++mf)
#pragma unroll
                    for (int nf = 0; nf < 3; ++nf) acc[mf][nf] = (f32x4){0.f, 0.f, 0.f, 0.f};
                const int fr = lane & 15, fq = lane >> 4;
#pragma unroll
                for (int ks = 0; ks < 4; ++ks) {
                    const int k0 = 128 * wave + 32 * ks + 8 * fq;
                    bf16x8 af[2], bfm[3];
#pragma unroll
                    for (int mf = 0; mf < 2; ++mf) af[mf] = *(const LAS bf16x8*)(At + (16 * mf + fr) * 2064 + k0 * 2);
#pragma unroll
                    for (int nf = 0; nf < 3; ++nf) bfm[nf] = *(const bf16x8*)(Wr_t + (size_t)(16 * nf + fr) * 1024 + k0);
#pragma unroll
                    for (int mf = 0; mf < 2; ++mf)
#pragma unroll
                        for (int nf = 0; nf < 3; ++nf) acc[mf][nf] = __builtin_amdgcn_mfma_f32_16x16x32_bf16(af[mf], bfm[nf], acc[mf][nf], 0, 0, 0);
                }
#pragma unroll
                for (int mf = 0; mf < 2; ++mf)
#pragma unroll
                    for (int nf = 0; nf < 3; ++nf)
#pragma unroll
                        for (int i = 0; i < 4; ++i) red[(wave * 32 + 16 * mf + 4 * fq + i) * 49 + 16 * nf + fr] = acc[mf][nf][i];
            }
            __syncthreads();
            if (tid < 32) {
                const int m = row0 + tid;
                float gl[4];
#pragma unroll
                for (int c = 0; c < 4; ++c) { float v = args.in[17][c];
#pragma unroll
                    for (int w = 0; w < 8; ++w) v += red[(w * 32 + tid) * 49 + c]; gl[c] = v; }
                int gs = 0; float gmax = gl[0];
#pragma unroll
                for (int c = 1; c < 4; ++c) if (gl[c] > gmax) { gmax = gl[c]; gs = c; }
                float den = 0.f;
#pragma unroll
                for (int c = 0; c < 4; ++c) den += __expf(gl[c] - gmax);
                const float gate = 1.0f / den;
                float el[8];
#pragma unroll
                for (int e = 0; e < 8; ++e) { float v = args.in[19][gs * 8 + e];
#pragma unroll
                    for (int w = 0; w < 8; ++w) v += red[(w * 32 + tid) * 49 + 4 + gs * 8 + e]; el[e] = v; }
                int e0 = 0; float t0 = el[0];
#pragma unroll
                for (int e = 1; e < 8; ++e) if (el[e] > t0) { t0 = el[e]; e0 = e; }
                int e1 = -1; float t1 = -INFINITY;
#pragma unroll
                for (int e = 0; e < 8; ++e) if (e != e0 && el[e] > t1) { t1 = el[e]; e1 = e; }
                const float w0 = 1.0f / (1.0f + __expf(t1 - t0)), w1 = 1.0f - w0;
                const int ge0 = gs * 8 + e0, ge1 = gs * 8 + e1;
                volatile LAS unsigned* ecnt = (volatile LAS unsigned*)(lds + 120832); volatile LAS unsigned* ebase = ecnt + 32;
                ecnt[tid] = 0u;
                const int l0 = (int)__hip_atomic_fetch_add((LAS unsigned*)ecnt + ge0, 1u, __ATOMIC_RELAXED, __HIP_MEMORY_SCOPE_WAVEFRONT);
                const int l1 = (int)__hip_atomic_fetch_add((LAS unsigned*)ecnt + ge1, 1u, __ATOMIC_RELAXED, __HIP_MEMORY_SCOPE_WAVEFRONT);
                const unsigned mine = ecnt[tid];
                if (mine) ebase[tid] = atomicAdd(ctl + CW_CNT + 64 * tid, mine);
                const int p0 = (int)ebase[ge0] + l0, p1 = (int)ebase[ge1] + l1;
                list[ge0 * MTOK + p0] = m; listw[ge0 * MTOK + p0] = gate * w0;
                list[ge1 * MTOK + p1] = m; listw[ge1 * MTOK + p1] = gate * w1;
                *(int4*)(tokinfo + 4 * m) = make_int4(ge0, p0, ge1, p1);
            }
            __syncthreads();
        }
        if (BOTH(5)) GRID_BAR();
    }

    LAS int* tpre = (LAS int*)(lds + TPRE_OFF); LAS int* cnts = tpre + 64;
    if (IN(6) || IN(7) || IN(8)) {
        if (threadIdx.x < 64) { const int e = threadIdx.x & 31; const int c = (int)__hip_atomic_load(ctl + CW_CNT + 64 * e, RLX_AGENT); const int nt_ = (c + 255) >> 8; int inc = nt_;
#pragma unroll
            for (int o = 1; o < 32; o <<= 1) { const int v = __shfl_up(inc, o, 32); if (e >= o) inc += v; }
            if (threadIdx.x < 32) { cnts[e] = c; tpre[e] = inc - nt_; if (e == 31) tpre[32] = inc; } }
        __syncthreads();
    }
#ifndef REP_P6
#define REP_P6 1
#endif
    for (int rep6 = 0; rep6 < REP_P6; ++rep6)
    if (IN(6)) {
        MoeUpSched S{G, bx, tpre, cnts, list, (const char*)HB, (const char*)W13_t};
        EpiAct E{HG, listw};
        pg8::gemm_phase<EpiAct, MoeUpSched, false>(lds + RING_OFF, DM, S, E);
        if (BOTH(6)) GRID_BAR();
    }
#ifndef REP_P7
#define REP_P7 1
#endif
    for (int rep7 = 0; rep7 < REP_P7; ++rep7)
    if (IN(7)) {
        MoeDownSched S{G, bx, tpre, (const char*)HG, (const char*)W2_t};
        EpiY E{Y};
        pg8::gemm_phase<EpiY, MoeDownSched, false>(lds + RING_OFF, DEXP, S, E);
        if (BOTH(7)) GRID_BAR();
    }
    if (IN(8)) {
        PHASE_IDS();
        int tb = 0; if (lane < 32) tb = tpre[lane] * 256;
        for (int m0 = gw; m0 < MTOK; m0 += 2 * NGW) {
            const int m1 = (m0 + NGW < MTOK) ? m0 + NGW : m0; const bool two = m1 != m0;
            const int4 ia = *(const int4*)(tokinfo + 4 * m0), ib = *(const int4*)(tokinfo + 4 * m1);
            const int sa0 = __shfl(tb, ia.x) + ia.y, sa1 = __shfl(tb, ia.z) + ia.w, sb0 = __shfl(tb, ib.x) + ib.y, sb1 = __shfl(tb, ib.z) + ib.w;
            f32x4* oa = (f32x4*)(out + (size_t)m0 * DM) + lane; f32x4* ob = (f32x4*)(out + (size_t)m1 * DM) + lane;
            const f32x4* gta = (const f32x4*)(modv + ((m0 >> 13) * 6 + 5) * 1024) + lane; const f32x4* gtb = (const f32x4*)(modv + ((m1 >> 13) * 6 + 5) * 1024) + lane;
            const u32x2* ya0 = (const u32x2*)(Y + (size_t)sa0 * DM) + lane; const u32x2* ya1 = (const u32x2*)(Y + (size_t)sa1 * DM) + lane;
            const u32x2* yb0 = (const u32x2*)(Y + (size_t)sb0 * DM) + lane; const u32x2* yb1 = (const u32x2*)(Y + (size_t)sb1 * DM) + lane;
            u32x2 a0[4], a1[4], b0[4], b1[4]; f32x4 xa[4], xb[4];
#pragma unroll
            for (int j = 0; j < 4; ++j) { a0[j] = ya0[64 * j]; a1[j] = ya1[64 * j]; b0[j] = yb0[64 * j]; b1[j] = yb1[64 * j]; xa[j] = oa[64 * j]; xb[j] = ob[64 * j]; }
#define YSUM(A, C) (f32x4){__uint_as_float((A).x << 16) + __uint_as_float((C).x << 16), __uint_as_float((A).x & 0xffff0000u) + __uint_as_float((C).x & 0xffff0000u), \
                           __uint_as_float((A).y << 16) + __uint_as_float((C).y << 16), __uint_as_float((A).y & 0xffff0000u) + __uint_as_float((C).y & 0xffff0000u)}
#pragma unroll
            for (int j = 0; j < 4; ++j) oa[64 * j] = xa[j] + gta[64 * j] * YSUM(a0[j], a1[j]);
            if (two) {
#pragma unroll
                for (int j = 0; j < 4; ++j) ob[64 * j] = xb[j] + gtb[64 * j] * YSUM(b0[j], b1[j]); }
#undef YSUM
        }
    }
#ifdef TS_MASK
    TS_EV();
    if (blockIdx.x == 0 && threadIdx.x == 0) { unsigned long long tot = 0; for (int i = 0; i + 1 < tsn; ++i) if ((TS_MASK >> i) & 1u) tot += tsb[i + 1] - tsb[i];
        const unsigned long long t0 = __builtin_amdgcn_s_memrealtime(); while (__builtin_amdgcn_s_memrealtime() - t0 < tot) __builtin_amdgcn_s_sleep(8); }
#endif
#undef IN
#undef BOTH
#undef GRID_BAR
}

extern "C" void kernel_launch(void* const* d_in, const int* in_sizes, int n_in, void* d_out, int out_size, void* d_ws, size_t ws_size, hipStream_t stream) {
    static int grid = 0;
    if (grid == 0) {
        if (n_in != 23 || out_size != MTOK * DM || ws_size < WS_END) { fprintf(stderr, "kernel_launch: unexpected shapes (n_in %d out %d ws %zu)\n", n_in, out_size, ws_size); grid = -1; return; }
        int dev = 0, cus = 0, per_cu = 0;
        if (hipGetDevice(&dev) != hipSuccess || hipDeviceGetAttribute(&cus, hipDeviceAttributeMultiprocessorCount, dev) != hipSuccess) { grid = -1; return; }
        if (hipFuncSetAttribute((const void*)mega_fwd, hipFuncAttributeMaxDynamicSharedMemorySize, LDS_BYTES) != hipSuccess) { fprintf(stderr, "kernel_launch: hipFuncSetAttribute failed\n"); grid = -1; return; }
        if (hipOccupancyMaxActiveBlocksPerMultiprocessor(&per_cu, (const void*)mega_fwd, NWAVES * 64, LDS_BYTES) != hipSuccess || per_cu < 1) fprintf(stderr, "kernel_launch: occupancy query reports %d\n", per_cu);
        (void)hipGetLastError();
        grid = cus;
    }
    if (grid < 0) return;
    if (hipMemsetAsync((char*)d_ws + WS_CTL, 0, CTL_ZERO_BYTES, stream) != hipSuccess) return;
    Args a{};
    for (int i = 0; i < 23; ++i) a.in[i] = (const float*)d_in[i];
    a.out = (float*)d_out; a.ws = (unsigned char*)d_ws;
    if (MK_N_LAUNCHES == 1) { a.ph_lo = 0; a.ph_hi = N_PHASES; hipLaunchKernelGGL(mega_fwd, dim3(grid), dim3(NWAVES * 64), LDS_BYTES, stream, a); }
    else for (int p = 0; p < N_PHASES; ++p) { a.ph_lo = p; a.ph_hi = p + 1; hipLaunchKernelGGL(mega_fwd, dim3(grid), dim3(NWAVES * 64), LDS_BYTES, stream, a); }
}
```

```cpp
#include <hip/hip_runtime.h>
#include <hip/hip_bf16.h>
#include <cstdio>
#include <cstdint>
#include <cmath>

#define LAS __attribute__((address_space(3)))
#define GAS __attribute__((address_space(1)))
typedef unsigned short bf16_t;
typedef short bf16x8 __attribute__((ext_vector_type(8)));
typedef short s16x4 __attribute__((ext_vector_type(4)));
typedef _Float16 f16x8 __attribute__((ext_vector_type(8)));
typedef _Float16 f16x2 __attribute__((ext_vector_type(2)));
typedef float f32x4 __attribute__((ext_vector_type(4)));
typedef float f32x2 __attribute__((ext_vector_type(2)));
typedef float f32x16 __attribute__((ext_vector_type(16)));
typedef unsigned u32x4 __attribute__((ext_vector_type(4)));
typedef unsigned u32x2 __attribute__((ext_vector_type(2)));
typedef __bf16 bf16x2_t __attribute__((ext_vector_type(2)));

__device__ __forceinline__ unsigned cvtpk(float lo, float hi) { f32x2 v = {lo, hi}; bf16x2_t b = __builtin_convertvector(v, bf16x2_t); return __builtin_bit_cast(unsigned, b); }

namespace pg8 {
constexpr int BM = 256, BK = 64, HALF = 128, HTB = HALF * BK * 2, STAGE_BYTES = 8 * HTB, NXCD = 8, WGM = 8;
__host__ __device__ __forceinline__ int lds_byte(int r, int c) { const int st = (r >> 4) * 2 + (c >> 5), rr = r & 15, cc = c & 31, ob = rr * 64 + cc * 2; return st * 1024 + (ob ^ (((ob >> 9) & 1) << 5)); }
__host__ __device__ __forceinline__ void stage_rc(int b, int& R, int& C) { const int st = b / 1024, sb = b % 1024, swz = sb ^ (((sb >> 9) & 1) << 5); R = (st >> 1) * 16 + swz / 64; C = (st & 1) * 32 + (swz % 64) / 2; }
__host__ __device__ __forceinline__ int perm32(int rho) { const int n = rho >> 4, i = rho & 15; return 8 * (i >> 2) + 4 * n + (i & 3); }

struct Unit { int pm, pn; const char* a; const char* b; int e, loc0, cnt, pad; };


template <class Epi, class Sched, bool ALIGN_EPI = false>
__device__ __forceinline__ void gemm_phase(LAS unsigned char* lds, const int K, const Sched& S, const Epi& E) {
    int tid = threadIdx.x; asm volatile("" : "+v"(tid)); const int wid = __builtin_amdgcn_readfirstlane(tid >> 6), lane = tid & 63, wr = wid >> 2, wc = wid & 3, fr = lane & 15, fq = lane >> 4;
    const int nt = K / BK;
    Unit cur, nxt; int ui = 0;
    if (!S.next(0, cur)) return;
    int sR[2], sC[2];
#pragma unroll
    for (int i = 0; i < 2; ++i) stage_rc(tid * 16 + i * 8192, sR[i], sC[i]);
    unsigned vB[2][2], vA[2][2];
    LAS unsigned* xoff = (LAS unsigned*)(lds + 131072 + 2048) + tid * 4;
#pragma unroll
    for (int h = 0; h < 2; ++h)
#pragma unroll
        for (int i = 0; i < 2; ++i) { vB[h][i] = S.offB(h, sR[i], sC[i]); vA[h][i] = S.offA(cur, h, sR[i], sC[i]); }
    const size_t kstep = (size_t)(BK * 2);
    const unsigned ldsw = (unsigned)wid * 1024u;
    const int aoff = lds_byte(wr * 64 + fr, fq * 8), boff = lds_byte(wc * 32 + fr, fq * 8);
#define PG8_SA(b, h) (((b) * 2 + (h)) * HTB)
#define PG8_SB(b, h) ((4 + (b) * 2 + (h)) * HTB)
#define PG8_STAGE(bufoff, gbase, o0, o1) do { \
        __builtin_amdgcn_global_load_lds((const unsigned*)((const char*)(gbase) + (o0)), (LAS unsigned*)(lds + (bufoff) + ldsw), 16, 0, 0); \
        __builtin_amdgcn_global_load_lds((const unsigned*)((const char*)(gbase) + (o1)), (LAS unsigned*)(lds + (bufoff) + ldsw + 8192), 16, 0, 0); } while (0)
#define PG8_STA(bufoff, gbase, V, h) PG8_STAGE(bufoff, gbase, V[h][0], V[h][1])
#define PG8_LDA(dst, b, h) do { _Pragma("unroll") for (int m = 0; m < 4; ++m) _Pragma("unroll") for (int k = 0; k < 2; ++k) dst[m][k] = *(const LAS bf16x8*)(lds + PG8_SA(b, h) + aoff + m * 2048 + k * 1024); } while (0)
#define PG8_LDB(dst, b, h) do { _Pragma("unroll") for (int n = 0; n < 2; ++n) _Pragma("unroll") for (int k = 0; k < 2; ++k) dst[n][k] = *(const LAS bf16x8*)(lds + PG8_SB(b, h) + boff + n * 2048 + k * 1024); } while (0)
#define PG8_MMA(ai, bj, At, Bt) do { __builtin_amdgcn_s_setprio(1); _Pragma("unroll") for (int m = 0; m < 4; ++m) _Pragma("unroll") for (int n = 0; n < 2; ++n) _Pragma("unroll") for (int k = 0; k < 2; ++k) \
        acc[ai][bj][m][n] = __builtin_amdgcn_mfma_f32_16x16x32_bf16(Bt[n][k], At[m][k], acc[ai][bj][m][n], 0, 0, 0); __builtin_amdgcn_s_setprio(0); } while (0)
#define PG8_WAIT_V(n) asm volatile("s_waitcnt vmcnt(" #n ")" ::: "memory")
#define PG8_WAIT_L(n) asm volatile("s_waitcnt lgkmcnt(" #n ")" ::: "memory")
#define PG8_BAR __builtin_amdgcn_s_barrier()
#define PG8_SCHED __builtin_amdgcn_sched_barrier(0)
    f32x4 acc[2][2][4][2];
#pragma unroll
    for (int a = 0; a < 2; ++a)
#pragma unroll
        for (int b = 0; b < 2; ++b)
#pragma unroll
            for (int m = 0; m < 4; ++m)
#pragma unroll
                for (int n = 0; n < 2; ++n) acc[a][b][m][n] = (f32x4){0.f, 0.f, 0.f, 0.f};
    bf16x8 At[4][2], B0[2][2], B1[2][2];
    const char* cA = cur.a; const char* cB = cur.b;
    PG8_STA(PG8_SB(0, 0), cB, vB, 0); PG8_STA(PG8_SB(0, 1), cB, vB, 1); PG8_STA(PG8_SA(0, 0), cA, vA, 0); PG8_STA(PG8_SA(0, 1), cA, vA, 1);
    if (wr == 1) PG8_BAR;
    PG8_WAIT_V(2); PG8_BAR;
    PG8_STA(PG8_SB(1, 0), cB + kstep, vB, 0); PG8_STA(PG8_SA(1, 0), cA + kstep, vA, 0); PG8_STA(PG8_SB(1, 1), cB + kstep, vB, 1);
    PG8_WAIT_V(6); PG8_BAR;
    for (;;) {
        const bool has_next = S.next(ui + 1, nxt);
        const char* nA = has_next ? nxt.a : cA; const char* nB = has_next ? nxt.b : cB;
        if (Sched::GATHER) {
            if (has_next) {
#pragma unroll
                for (int i = 0; i < 2; ++i) { int t_ = tid; asm volatile("" : "+v"(t_)); int R_, C_; stage_rc(t_ * 16 + i * 8192, R_, C_);
#pragma unroll
                    for (int h = 0; h < 2; ++h) xoff[h * 2 + i] = S.offA(nxt, h, R_, C_); }
            }
        }
        for (int t = 0; t < nt; t += 2) {
            const bool last = (t == nt - 2);
            const char* a1 = cA + (size_t)(t + 1) * kstep;
            const char* a2 = last ? nA : cA + (size_t)(t + 2) * kstep; const char* b2 = last ? nB : cB + (size_t)(t + 2) * kstep;
            const char* a3 = a2 + kstep; const char* b3 = b2 + kstep;
            PG8_LDB(B0, 0, 0); PG8_LDB(B1, 0, 1); PG8_SCHED; PG8_LDA(At, 0, 0); PG8_STA(PG8_SA(1, 1), a1, vA, 1);
            PG8_WAIT_V(8); PG8_WAIT_L(0); PG8_BAR; PG8_MMA(0, 0, At, B0); PG8_MMA(0, 1, At, B1); PG8_BAR; PG8_SCHED;
            if (Sched::GATHER) { if (last && has_next) { vA[0][0] = xoff[0]; vA[0][1] = xoff[1]; vA[1][0] = xoff[2]; vA[1][1] = xoff[3]; } }
            PG8_LDA(At, 0, 1); PG8_STA(PG8_SB(0, 0), b2, vB, 0); PG8_STA(PG8_SB(0, 1), b2, vB, 1); PG8_STA(PG8_SA(0, 0), a2, vA, 0);
            PG8_WAIT_V(8); PG8_WAIT_L(0); PG8_BAR; PG8_MMA(1, 0, At, B0); PG8_MMA(1, 1, At, B1); PG8_BAR; PG8_SCHED;
            PG8_LDB(B0, 1, 0); PG8_LDB(B1, 1, 1); PG8_SCHED; PG8_LDA(At, 1, 0); PG8_STA(PG8_SA(0, 1), a2, vA, 1);
            PG8_WAIT_V(8); PG8_WAIT_L(0); PG8_BAR; PG8_MMA(0, 0, At, B0); PG8_MMA(0, 1, At, B1); PG8_BAR; PG8_SCHED;
            PG8_LDA(At, 1, 1); PG8_STA(PG8_SB(1, 0), b3, vB, 0); PG8_STA(PG8_SB(1, 1), b3, vB, 1); PG8_STA(PG8_SA(1, 0), a3, vA, 0);
            PG8_WAIT_V(8); PG8_WAIT_L(0); PG8_BAR; PG8_MMA(1, 0, At, B0); PG8_MMA(1, 1, At, B1); PG8_BAR; PG8_SCHED;
        }
        if constexpr (ALIGN_EPI) { if (wr == 0) PG8_BAR; }
        E(acc, cur, wr, wc, fr, fq);
        if (!has_next) break;
#pragma unroll
        for (int a = 0; a < 2; ++a)
#pragma unroll
            for (int b = 0; b < 2; ++b)
#pragma unroll
                for (int m = 0; m < 4; ++m)
#pragma unroll
                    for (int n = 0; n < 2; ++n) acc[a][b][m][n] = (f32x4){0.f, 0.f, 0.f, 0.f};
        cur = nxt; cA = nA; cB = nB; ++ui;
        if constexpr (ALIGN_EPI) { if (wr == 1) PG8_BAR; }
    }
    PG8_WAIT_V(0);
    if constexpr (!ALIGN_EPI) { if (wr == 0) PG8_BAR; }
    PG8_BAR;
#undef PG8_SA
#undef PG8_SB
#undef PG8_STAGE
#undef PG8_STA
#undef PG8_LDA
#undef PG8_LDB
#undef PG8_MMA
#undef PG8_WAIT_V
#undef PG8_WAIT_L
#undef PG8_BAR
#undef PG8_SCHED
}
}

constexpr int BATCH = 2, SEQ = 8192, DM = 1024, MTOK = BATCH * SEQ, INC = 3072;
constexpr int NEXP = 32, DEXP = 256, NWAVES = 8;
constexpr float EPS = 1e-6f, LOG2E = 1.4426950408889634f;
constexpr float LAMBDA_INIT = 0.2f;
constexpr int MAXTILES = 160, MAXSLOTS = MAXTILES * 256;

constexpr size_t MiB = 1u << 20;
constexpr size_t WS_CTL = 0, CTL_ZERO_BYTES = 64 * 1024;
constexpr size_t WS_MODV = 1 * MiB;
constexpr size_t WS_WR = 1 * MiB + 256 * 1024;
constexpr size_t WS_WIN = 2 * MiB;
constexpr size_t WS_WOUT = 8 * MiB;
constexpr size_t WS_W13 = 10 * MiB;
constexpr size_t WS_W2 = 42 * MiB;
constexpr size_t WS_HB = 58 * MiB;
constexpr size_t WS_QD = 90 * MiB, WS_KD = 106 * MiB, WS_VD = 122 * MiB, WS_QS = 138 * MiB, WS_KS = 154 * MiB, WS_VS = 170 * MiB;
constexpr size_t WS_AO = 186 * MiB;
constexpr size_t WS_ROUTE = 218 * MiB;
constexpr size_t WS_LIST = WS_ROUTE + 256 * 1024, WS_LISTW = WS_LIST + 2 * MiB;
constexpr size_t WS_HG = 90 * MiB;
constexpr size_t WS_Y = 110 * MiB;
constexpr size_t WS_END = 224 * MiB;
static_assert(WS_HG + (size_t)MAXSLOTS * 256 * 2 <= WS_Y && WS_Y + (size_t)MAXSLOTS * 1024 * 2 <= WS_ROUTE && WS_LISTW + 2 * MiB <= WS_END, "ws map");
constexpr int CW_CNT = 256;
constexpr int CW_QUEUE = 128;
constexpr int CW_BAR = 4096;

constexpr int RING_OFF = 0, RING_BYTES = 131072;
constexpr int LDSCTL_OFF = RING_BYTES, MISC_OFF = LDSCTL_OFF + 320;
constexpr int TPRE_OFF = LDSCTL_OFF + 1024;
constexpr int LDS_BYTES = 147456;

typedef GAS unsigned gu32;
#define RLX_AGENT __ATOMIC_RELAXED, __HIP_MEMORY_SCOPE_AGENT
#define LDS_WAIT() asm volatile("s_waitcnt lgkmcnt(0)" ::: "memory")
#define VM_WAIT() asm volatile("s_waitcnt vmcnt(0)" ::: "memory")

#define XB_TMO      128
#define XB_XCNT(j)  (256  + 64 * (j))
#define XB_XSUB(j)  (1280 + 64 * (j))
#define XB_XGEN(j)  (2304 + 64 * (j))
#define XB_TOP      3328
#define XB_TOPGEN   3392
#define XCD_BAR_WORDS 3456
#define XB_SPIN_CAP (1u << 20)
__device__ __forceinline__ unsigned xb_ld(unsigned* p)              { return __hip_atomic_load(p, __ATOMIC_RELAXED, __HIP_MEMORY_SCOPE_AGENT); }
__device__ __forceinline__ unsigned xb_add(unsigned* p, unsigned v) { return __hip_atomic_fetch_add(p, v, __ATOMIC_RELAXED, __HIP_MEMORY_SCOPE_AGENT); }
__device__ __forceinline__ unsigned xb_xcc_id() { return (unsigned)__builtin_amdgcn_s_getreg((3 << 11) | 20) & 0xFu; }
#define XB_SPIN(cond, bar) do { unsigned _sp = 0; while (cond) { __builtin_amdgcn_s_sleep(1); \
    if ((++_sp & 255u) == 0u) { if (xb_ld(&(bar)[XB_TMO])) break; if (_sp > XB_SPIN_CAP) { atomicAdd(&(bar)[XB_TMO], 1u); break; } } } } while (0)
struct XcdBarrier { unsigned* bar; unsigned x; volatile LAS unsigned* st; };
__device__ __forceinline__ XcdBarrier xcd_barrier_post(unsigned* bar, volatile LAS unsigned* st) {
    XcdBarrier b; b.bar = bar; b.x = xb_xcc_id(); b.st = st;
    if (threadIdx.x == 0) (void)xb_add(&bar[XB_XCNT(b.x)], 1u);
    return b;
}
__device__ __forceinline__ void xcd_barrier_complete(unsigned* bar, unsigned x, unsigned& nloc, unsigned& nx) {
    const unsigned G = gridDim.x * gridDim.y * gridDim.z;
    unsigned sum, cnt, mine, sp = 0u;
    for (;;) {
        sum = 0u; cnt = 0u; mine = 0u;
#pragma unroll
        for (unsigned j = 0; j < 16; ++j) { const unsigned c = xb_ld(&bar[XB_XCNT(j)]); sum += c; cnt += (c > 0u) ? 1u : 0u; mine = (j == x) ? c : mine; }
        if (sum == G) break;
        __builtin_amdgcn_s_sleep(1);
        if ((++sp & 255u) == 0u) { if (xb_ld(&bar[XB_TMO])) break; if (sp > XB_SPIN_CAP) { atomicAdd(&bar[XB_TMO], 1u); break; } }
    }
    nloc = mine > 0u ? mine : 1u; nx = cnt > 0u ? cnt : 1u;
}
__device__ __forceinline__ void xcd_barrier(const XcdBarrier& b) {
    asm volatile("s_waitcnt vmcnt(0)" ::: "memory");
    __syncthreads();
    if (threadIdx.x == 0) {
        unsigned* bar = b.bar;
        __builtin_amdgcn_s_waitcnt(0);
        unsigned nloc = b.st[0], nx = b.st[1];
        if (nloc == 0u) { xcd_barrier_complete(bar, b.x, nloc, nx); b.st[0] = nloc; b.st[1] = nx; }
        const unsigned old = xb_add(&bar[XB_XSUB(b.x)], 1u);
        const unsigned gen = old / nloc;
        if (old + 1u == (gen + 1u) * nloc) {
            __builtin_amdgcn_fence(__ATOMIC_RELEASE, "agent");
            asm volatile("s_waitcnt vmcnt(0)" ::: "memory");
            const unsigned og = xb_add(&bar[XB_TOP], 1u);
            const unsigned tg = og / nx;
            if (og + 1u == (tg + 1u) * nx) xb_add(&bar[XB_TOPGEN], 1u);
            else XB_SPIN(xb_ld(&bar[XB_TOPGEN]) == tg, bar);
            __builtin_amdgcn_fence(__ATOMIC_ACQUIRE, "agent");
            xb_add(&bar[XB_XGEN(b.x)], 1u);
            asm volatile("s_waitcnt vmcnt(0)" ::: "memory");
        } else {
            XB_SPIN(xb_ld(&bar[XB_XGEN(b.x)]) == gen, bar);
            __builtin_amdgcn_fence(__ATOMIC_ACQUIRE, "agent");
            asm volatile("s_waitcnt vmcnt(0)" ::: "memory");
        }
    }
    __syncthreads();
}

__device__ __forceinline__ float wave_sum(float v) {
#pragma unroll
    for (int o = 1; o < 64; o <<= 1) v += __shfl_xor(v, o);
    return v;
}
__device__ __forceinline__ float wave_max(float v) {
#pragma unroll
    for (int o = 1; o < 64; o <<= 1) v = fmaxf(v, __shfl_xor(v, o));
    return v;
}
__device__ __forceinline__ unsigned f2bf(float f) { unsigned u = __builtin_bit_cast(unsigned, f); return (u + 0x7fffu + ((u >> 16) & 1u)) >> 16; }
__device__ __forceinline__ unsigned pk2(float lo, float hi) { return f2bf(lo) | (f2bf(hi) << 16); }
__device__ __forceinline__ float bf2f(unsigned short h) { return __builtin_bit_cast(float, (unsigned)h << 16); }

struct DenseSched {
    static constexpr bool GATHER = false;
    int nM, nN, nwg, G, c, K; const char* A; const char* B; int bmode;
    bool perm;
    __device__ __forceinline__ bool next(int i, pg8::Unit& u) const {
        const long L = (long)i * G + c; if (L >= nwg) return false;
        int wgid = (int)L; { const int q = nwg / pg8::NXCD, r = nwg % pg8::NXCD, xcd = wgid % pg8::NXCD, off = wgid / pg8::NXCD; wgid = (xcd < r ? xcd * (q + 1) : r * (q + 1) + (xcd - r) * q) + off; }
        const int nig = pg8::WGM * nN, gid = wgid / nig, fm = gid * pg8::WGM, gsz = (nM - fm) < pg8::WGM ? (nM - fm) : pg8::WGM;
        u.pm = fm + ((wgid % nig) % gsz); u.pn = (wgid % nig) / gsz;
        u.a = A + (size_t)u.pm * 256 * K * 2; u.b = B + (size_t)u.pn * 256 * K * 2; u.e = 0; u.loc0 = 0; u.cnt = 0; u.pad = 0; return true;
    }
    __device__ __forceinline__ unsigned offA(const pg8::Unit&, int h, int R, int C) const { return (unsigned)((h * 128 + R) * K + C) * 2u; }
    __device__ __forceinline__ unsigned offB(int h, int R, int C) const {
        int row;
        if (bmode == 1) row = 64 * (R >> 5) + 32 * h + pg8::perm32(R & 31);
        else row = h * 128 + (perm ? ((R & ~31) + pg8::perm32(R & 31)) : R);
        return (unsigned)(row * K + C) * 2u;
    }
};

struct EpiQKV {
    bf16_t *Qd, *Kd, *Vd, *Qs, *Ks, *Vs; const float *gq, *gk;
    __device__ __forceinline__ void operator()(const f32x4 (&acc)[2][2][4][2], const pg8::Unit& u, int wr, int wc, int fr, int fq) const {
        asm volatile("" : "+v"(fr), "+v"(fq));
        const int pn = u.pn, sec = pn >> 1, G = 4 * (pn & 1) + wc;
        const int row0 = u.pm * 256 + wr * 64 + fr;
        const int b = row0 >> 13;
        float gv[2][2][4];
        if (sec < 2) { const float* g = sec == 0 ? gq : gk; const float sc = sec == 0 ? (0.125f * LOG2E) : 1.0f;
#pragma unroll
            for (int bj = 0; bj < 2; ++bj)
#pragma unroll
                for (int n = 0; n < 2; ++n) { const f32x4 t = *(const f32x4*)(g + 32 * bj + 8 * fq + 4 * n); gv[bj][n][0] = t[0] * sc; gv[bj][n][1] = t[1] * sc; gv[bj][n][2] = t[2] * sc; gv[bj][n][3] = t[3] * sc; }
        }
#pragma unroll
        for (int ai = 0; ai < 2; ++ai)
#pragma unroll
            for (int m = 0; m < 4; ++m) {
                const int row = row0 + ai * 128 + m * 16, s = row & (SEQ - 1);
                f32x4 v[2][2];
#pragma unroll
                for (int bj = 0; bj < 2; ++bj)
#pragma unroll
                    for (int n = 0; n < 2; ++n) v[bj][n] = acc[ai][bj][m][n];
                if (sec < 2) {
                    float ss = 0.f;
#pragma unroll
                    for (int bj = 0; bj < 2; ++bj)
#pragma unroll
                        for (int n = 0; n < 2; ++n) ss += (v[bj][n][0] * v[bj][n][0] + v[bj][n][1] * v[bj][n][1]) + (v[bj][n][2] * v[bj][n][2] + v[bj][n][3] * v[bj][n][3]);
                    ss += __shfl_xor(ss, 16); ss += __shfl_xor(ss, 32);
                    const float r = __builtin_amdgcn_rsqf(ss * (1.0f / 64.0f) + EPS);
#pragma unroll
                    for (int bj = 0; bj < 2; ++bj)
#pragma unroll
                        for (int n = 0; n < 2; ++n)
#pragma unroll
                            for (int i = 0; i < 4; ++i) v[bj][n][i] = v[bj][n][i] * r * gv[bj][n][i];
                } else if (sec == 3) {
#pragma unroll
                    for (int bj = 0; bj < 2; ++bj)
#pragma unroll
                        for (int n = 0; n < 2; ++n) v[bj][n] = v[bj][n] * (0.125f * LOG2E);
                }
#pragma unroll
                for (int bj = 0; bj < 2; ++bj) {
                    u32x4 w; w.x = cvtpk(v[bj][0][0], v[bj][0][1]); w.y = cvtpk(v[bj][0][2], v[bj][0][3]); w.z = cvtpk(v[bj][1][0], v[bj][1][1]); w.w = cvtpk(v[bj][1][2], v[bj][1][3]);
                    size_t off; bf16_t* base;
                    if (sec == 0 || sec == 3) {
                        base = sec == 0 ? Qd : Qs; off = ((size_t)(b * 8 + G) * SEQ + s) * 64 + 32 * bj + 8 * fq;
                    } else if (sec == 1 || sec == 4) {
                        base = sec == 1 ? Kd : Ks; off = ((((size_t)(b * 8 + G) * 128 + (s >> 6)) * 8 + 4 * bj + fq) * 64 + (s & 63)) * 8;
                    } else if (sec == 2) {
                        base = Vd; off = (((((size_t)(b * 4 + (G >> 1)) * 128 + (s >> 6)) * 4 + 2 * (G & 1) + bj) * 4 + ((s & 63) >> 4)) * 16 + (s & 15)) * 32 + 8 * fq;
                    } else {
                        base = Vs; off = (((((size_t)(b * 8 + G) * 128 + (s >> 6)) * 2 + bj) * 4 + ((s & 63) >> 4)) * 16 + (s & 15)) * 32 + 8 * fq;
                    }
                    *(u32x4*)(base + off) = w;
                }
            }
    }
};

struct EpiX1 {
    const float* x; float* out; const float* gt;
    __device__ __forceinline__ void operator()(const f32x4 (&acc)[2][2][4][2], const pg8::Unit& u, int wr, int wc, int fr, int fq) const {
        asm volatile("" : "+v"(fr), "+v"(fq));
        const int row0 = u.pm * 256 + wr * 64 + fr, b = row0 >> 13, col0 = u.pn * 256 + wc * 32 + 8 * fq;
        f32x4 g[2][2];
#pragma unroll
        for (int bj = 0; bj < 2; ++bj)
#pragma unroll
            for (int n = 0; n < 2; ++n) g[bj][n] = *(const f32x4*)(gt + (size_t)b * 6144 + col0 + bj * 128 + n * 4);
#pragma unroll
        for (int ai = 0; ai < 2; ++ai)
#pragma unroll
            for (int m = 0; m < 4; ++m) { const size_t off = (size_t)(row0 + ai * 128 + m * 16) * DM + col0;
                f32x4 xv[2][2];
#pragma unroll
                for (int bj = 0; bj < 2; ++bj)
#pragma unroll
                    for (int n = 0; n < 2; ++n) xv[bj][n] = *(const f32x4*)(x + off + bj * 128 + n * 4);
#pragma unroll
                for (int bj = 0; bj < 2; ++bj)
#pragma unroll
                    for (int n = 0; n < 2; ++n) *(f32x4*)(out + off + bj * 128 + n * 4) = xv[bj][n] + g[bj][n] * acc[ai][bj][m][n]; }
    }
};

struct MoeUpSched {
    static constexpr bool GATHER = true;
    int G, c; const LAS int* tpre; const LAS int* cnts; const int* list; const char* A; const char* B;
    __device__ __forceinline__ bool next(int i, pg8::Unit& u) const {
        const int L = i * G + c, T = tpre[32]; if (L >= 2 * T) return false;
        const int tau = L >> 1, pn = L & 1; int e = 0;
#pragma unroll 1
        for (int j = 1; j < 32; ++j) if (tpre[j] <= tau) e = j;
        u.pm = tau; u.pn = pn; u.e = e; u.loc0 = (tau - tpre[e]) * 256; u.cnt = cnts[e]; u.pad = 0;
        u.a = A; u.b = B + ((size_t)e * 512 + 128 * pn) * 1024 * 2; return true;
    }
    __device__ __forceinline__ unsigned offA(const pg8::Unit& u, int h, int R, int C) const {
        const int loc = u.loc0 + h * 128 + R; int tok = 0;
        if (loc < u.cnt) tok = list[u.e * MTOK + loc];
        return (unsigned)(tok * 1024 + C) * 2u;
    }
    __device__ __forceinline__ unsigned offB(int h, int R, int C) const { return (unsigned)((256 * h + (R & ~31) + pg8::perm32(R & 31)) * 1024 + C) * 2u; }
};
struct EpiAct {
    bf16_t* hg; const float* listw;
    __device__ __forceinline__ void operator()(const f32x4 (&acc)[2][2][4][2], const pg8::Unit& u, int wr, int wc, int fr, int fq) const {
        asm volatile("" : "+v"(fr), "+v"(fq));
        const int col0 = 128 * u.pn + 32 * wc + 8 * fq;
#pragma unroll
        for (int ai = 0; ai < 2; ++ai)
#pragma unroll
            for (int m = 0; m < 4; ++m) {
                const int rl = 128 * ai + 64 * wr + 16 * m + fr, loc = u.loc0 + rl;
                float w = 0.f; if (loc < u.cnt) w = listw[u.e * MTOK + loc];
                float o[8];
#pragma unroll
                for (int n = 0; n < 2; ++n)
#pragma unroll
                    for (int i = 0; i < 4; ++i) { const float a = acc[ai][0][m][n][i], g = acc[ai][1][m][n][i]; const float sg = a * __builtin_amdgcn_rcpf(1.0f + __builtin_amdgcn_exp2f(-a * LOG2E)); o[4 * n + i] = sg * g * w; }
                u32x4 q; q.x = cvtpk(o[0], o[1]); q.y = cvtpk(o[2], o[3]); q.z = cvtpk(o[4], o[5]); q.w = cvtpk(o[6], o[7]);
                *(u32x4*)(hg + ((size_t)u.pm * 256 + rl) * DEXP + col0) = q;
            }
    }
};
struct MoeDownSched {
    static constexpr bool GATHER = false;
    int G, c; const LAS int* tpre; const char* A; const char* B;
    __device__ __forceinline__ bool next(int i, pg8::Unit& u) const {
        const int L = i * G + c, T = tpre[32]; if (L >= 4 * T) return false;
        const int tau = L >> 2, pn = L & 3; int e = 0;
#pragma unroll 1
        for (int j = 1; j < 32; ++j) if (tpre[j] <= tau) e = j;
        u.pm = tau; u.pn = pn; u.e = e; u.loc0 = 0; u.cnt = 0; u.pad = 0;
        u.a = A + (size_t)tau * 256 * DEXP * 2; u.b = B + ((size_t)e * 1024 + 256 * pn) * DEXP * 2; return true;
    }
    __device__ __forceinline__ unsigned offA(const pg8::Unit&, int h, int R, int C) const { return (unsigned)((h * 128 + R) * DEXP + C) * 2u; }
    __device__ __forceinline__ unsigned offB(int h, int R, int C) const { return (unsigned)((h * 128 + (R & ~31) + pg8::perm32(R & 31)) * DEXP + C) * 2u; }
};
struct EpiY {
    bf16_t* y;
    __device__ __forceinline__ void operator()(const f32x4 (&acc)[2][2][4][2], const pg8::Unit& u, int wr, int wc, int fr, int fq) const {
        asm volatile("" : "+v"(fr), "+v"(fq));
        const int col0 = 256 * u.pn + 32 * wc + 8 * fq;
#pragma unroll
        for (int ai = 0; ai < 2; ++ai)
#pragma unroll
            for (int m = 0; m < 4; ++m) { bf16_t* rowp = y + ((size_t)u.pm * 256 + 128 * ai + 64 * wr + 16 * m + fr) * DM + col0;
#pragma unroll
                for (int bj = 0; bj < 2; ++bj) { const f32x4 v0 = acc[ai][bj][m][0], v1 = acc[ai][bj][m][1];
                    u32x4 w; w.x = cvtpk(v0[0], v0[1]); w.y = cvtpk(v0[2], v0[3]); w.z = cvtpk(v1[0], v1[1]); w.w = cvtpk(v1[2], v1[3]);
                    *(u32x4*)(rowp + bj * 128) = w; } }
    }
};

namespace att {
constexpr float ZTHR = 170.0f;
__device__ __forceinline__ int crow(int r, int hi) { return (r & 3) + 8 * (r >> 2) + 4 * hi; }
__device__ __forceinline__ s16x4 vtr(const LAS unsigned char* p) { return __builtin_bit_cast(s16x4, __builtin_amdgcn_ds_read_tr16_b64_v4i16((LAS s16x4*)p)); }
__device__ __forceinline__ bf16x8 cat8(s16x4 lo, s16x4 hi) { return (bf16x8){lo[0], lo[1], lo[2], lo[3], hi[0], hi[1], hi[2], hi[3]}; }
__device__ __forceinline__ float swap_add(float v) { auto rr = __builtin_amdgcn_permlane32_swap(__float_as_uint(v), __float_as_uint(v), false, false); return __uint_as_float(rr[0]) + __uint_as_float(rr[1]); }

struct AttnP {
    const bf16_t *Qd, *Kd, *Vd, *Qs, *Ks, *Vs; bf16_t* AO;
    const float *gq, *gk, *lq1, *lk1, *lq2, *lk2, *dog, *sog;
};

#define ATT_WAITBAR(N) asm volatile("s_waitcnt vmcnt(" #N ") lgkmcnt(0)\n\ts_barrier" ::: "memory")
#define GLDS16(src, dstoff) __builtin_amdgcn_global_load_lds((const unsigned*)(src), (LAS unsigned*)(lds + (dstoff) + ldsw), 16, 0, 0)
__device__ __forceinline__ void diff_unit(const AttnP& P, int b, int hh, int iq, LAS unsigned char* lds, float lam, float Mp) {
    int tid = threadIdx.x; asm volatile("" : "+v"(tid)); const int lane = tid & 63, r32 = lane & 31, hi = lane >> 5;
    const int wid = __builtin_amdgcn_readfirstlane(tid >> 6), mp = wid >> 2, rg = wid & 3;
    const int q0 = iq * 128, qw0 = q0 + 32 * rg, NT = 2 * (iq + 1);
    const int vh = 2 * hh + mp;
    const float slope = exp2f(-2.0f * (float)(hh + 1)) * LOG2E;
    const bf16_t* Qg = P.Qd + ((size_t)(b * 8 + vh) * SEQ + qw0 + r32) * 64;
    const unsigned char* K0g = (const unsigned char*)(P.Kd + (size_t)(b * 8 + 2 * hh) * SEQ * 64) + tid * 16;
    const unsigned char* K1g = (const unsigned char*)(P.Kd + (size_t)(b * 8 + 2 * hh + 1) * SEQ * 64) + tid * 16;
    const unsigned char* Vg = (const unsigned char*)(P.Vd + (size_t)(b * 4 + hh) * SEQ * 128) + tid * 16;
    bf16x8 qf[4];
#pragma unroll
    for (int s = 0; s < 4; ++s) qf[s] = *(const bf16x8*)(Qg + 16 * s + 8 * hi);
    const float lbase = slope * (float)(4 * hi - r32);
    f32x16 o[4];
#pragma unroll
    for (int d = 0; d < 4; ++d) o[d] = f32x16{};
    float lsum = 0.f;
    const unsigned ldsw = (unsigned)wid * 1024u;
#define DLOAD(j) do { const int so_ = ((j) & 3) * 32768; GLDS16(K0g + (size_t)(j) * 8192, so_); GLDS16(K1g + (size_t)(j) * 8192, so_ + 8192); \
        GLDS16(Vg + (size_t)(j) * 16384, so_ + 16384); GLDS16(Vg + (size_t)(j) * 16384 + 8192, so_ + 24576); } while (0)
#define DQK(P0, P1, j) do { const LAS unsigned char* Kb_ = lds + ((j) & 3) * 32768 + mp * 8192 + hi * 1024 + r32 * 16; \
        const float T0_ = -Mp - slope * (float)(qw0 - 64 * (j)) + lbase, T1_ = T0_ + 32.0f * slope; \
        _Pragma("unroll") for (int r = 0; r < 16; ++r) { const float cr = (float)((r & 3) + 8 * (r >> 2)); P0[r] = fmaf(slope, cr, T0_); P1[r] = fmaf(slope, cr, T1_); } \
        _Pragma("unroll") for (int s = 0; s < 4; ++s) { \
            const bf16x8 a0 = *(const LAS bf16x8*)(Kb_ + s * 2048), a1 = *(const LAS bf16x8*)(Kb_ + s * 2048 + 512); \
            P0 = __builtin_amdgcn_mfma_f32_32x32x16_bf16(a0, qf[s], P0, 0, 0, 0); \
            P1 = __builtin_amdgcn_mfma_f32_32x32x16_bf16(a1, qf[s], P1, 0, 0, 0); } } while (0)
    const int jlast = (qw0 + 31) >> 6;
    const float dwin = ZTHR / slope;
    const int jstart = max(0, (int)floorf(((float)q0 - dwin - 63.0f) * (1.0f / 64.0f)) + 1);
    const int jfirst = max(jstart, (int)floorf(((float)qw0 - dwin - 63.0f) * (1.0f / 64.0f)) + 1);
    DLOAD(jstart); if (jstart + 1 < NT) DLOAD(jstart + 1);
    if (jstart + 1 < NT) ATT_WAITBAR(4); else ATT_WAITBAR(0);
    f32x16 p0, p1, n0, n1;
    bf16x8 pf0, pf1, pf2, pf3;
    if (jfirst == jstart) DQK(p0, p1, jstart);
    const int vlane = ((lane >> 4) & 1) * 32 + (lane & 3) * 8 + (4 * hi + ((lane & 15) >> 2)) * 64;
#define PACK8(P, B) __builtin_bit_cast(bf16x8, (u32x4){cvtpk(P[B + 0], P[B + 1]), cvtpk(P[B + 2], P[B + 3]), cvtpk(P[B + 4], P[B + 5]), cvtpk(P[B + 6], P[B + 7])})
#define DPART1(DIAG, NEXT, j) do { \
        if (NEXT) DQK(n0, n1, (j) + 1); \
        if (DIAG) { const int dq = qw0 + r32 - 64 * (j); \
            _Pragma("unroll") for (int r = 0; r < 16; ++r) { const int k0 = crow(r, hi); if (k0 > dq) p0[r] = -1e30f; if (k0 + 32 > dq) p1[r] = -1e30f; } } \
        _Pragma("unroll") for (int r = 0; r < 16; ++r) p0[r] = __builtin_amdgcn_exp2f(p0[r]); \
        float sa = 0.f; \
        _Pragma("unroll") for (int r = 0; r < 16; ++r) sa += p0[r]; \
        pf0 = PACK8(p0, 0); pf1 = PACK8(p0, 8); \
        _Pragma("unroll") for (int r = 0; r < 16; ++r) p1[r] = __builtin_amdgcn_exp2f(p1[r]); \
        float sb = 0.f; \
        _Pragma("unroll") for (int r = 0; r < 16; ++r) sb += p1[r]; \
        lsum += sa + sb; \
        pf2 = PACK8(p1, 0); pf3 = PACK8(p1, 8); \
        if (NEXT) { p0 = n0; p1 = n1; } } while (0)
#define DPART2(jj) do { const LAS unsigned char* Vb = lds + ((jj) & 3) * 32768 + 16384 + vlane; \
        _Pragma("unroll") for (int d = 0; d < 4; ++d) { \
            o[d] = __builtin_amdgcn_mfma_f32_32x32x16_bf16(cat8(vtr(Vb + d * 4096), vtr(Vb + d * 4096 + 512)), pf0, o[d], 0, 0, 0); \
            o[d] = __builtin_amdgcn_mfma_f32_32x32x16_bf16(cat8(vtr(Vb + d * 4096 + 1024), vtr(Vb + d * 4096 + 1024 + 512)), pf1, o[d], 0, 0, 0); \
            o[d] = __builtin_amdgcn_mfma_f32_32x32x16_bf16(cat8(vtr(Vb + d * 4096 + 2048), vtr(Vb + d * 4096 + 2048 + 512)), pf2, o[d], 0, 0, 0); \
            o[d] = __builtin_amdgcn_mfma_f32_32x32x16_bf16(cat8(vtr(Vb + d * 4096 + 3072), vtr(Vb + d * 4096 + 3072 + 512)), pf3, o[d], 0, 0, 0); } } while (0)
#define DTOP(j) do { ATT_WAITBAR(0); if ((j) + 2 < NT) DLOAD((j) + 2); } while (0)
    int j = jstart;
    for (; j < jfirst; ++j) { DTOP(j); if (j + 1 == jfirst) DQK(p0, p1, j + 1); }
#ifndef ATT_STAGGER
#define ATT_STAGGER 0
#endif
    if (mp == 0 || !ATT_STAGGER) {
        for (; j < jlast; ++j) { DTOP(j); DPART1(false, true, j); DPART2(j); }
        DTOP(j); DPART1(true, false, j); DPART2(j); ++j;
    } else {
        if (j < jlast) {
            DTOP(j); DPART1(false, true, j); ++j;
            for (; j < jlast; ++j) { DTOP(j); DPART2(j - 1); DPART1(false, true, j); }
            DTOP(j); DPART2(j - 1); DPART1(true, false, j); ++j;
        } else { DTOP(j); DPART1(true, false, j); ++j; }
        DTOP(j); DPART2(j - 1); ++j;
    }
    for (; j <= NT; ++j) { DTOP(j); }
#undef DPART1
#undef DPART2
#undef DTOP
#undef PACK8
#undef DLOAD
#undef DQK
    ATT_WAITBAR(0);
    lsum = swap_add(lsum);
    const float inv = 1.0f / lsum;
    LAS float* exch = (LAS float*)lds + rg * 4096;
    if (mp == 1) {
#pragma unroll
        for (int d = 0; d < 4; ++d)
#pragma unroll
            for (int r = 0; r < 16; ++r) exch[(32 * d + crow(r, hi)) * 32 + r32] = o[d][r] * inv;
    }
    __syncthreads();
    if (mp == 0) {
        float ss = 0.f;
#pragma unroll
        for (int d = 0; d < 4; ++d)
#pragma unroll
            for (int r = 0; r < 16; ++r) { const float v = o[d][r] * inv - lam * exch[(32 * d + crow(r, hi)) * 32 + r32]; o[d][r] = v; ss += v * v; }
        ss = swap_add(ss);
        const float rr = __builtin_amdgcn_rsqf(ss * (1.0f / 128.0f) + EPS) * (1.0f - LAMBDA_INIT);
        LAS unsigned char* stg = lds + 65536 + rg * 8704;
#pragma unroll
        for (int d = 0; d < 4; ++d)
#pragma unroll
            for (int r = 0; r < 16; r += 2) { const int dd = 32 * d + crow(r, hi);
                *(LAS unsigned*)(stg + r32 * 272 + dd * 2) = cvtpk(o[d][r] * rr * P.dog[dd], o[d][r + 1] * rr * P.dog[dd + 1]); }
        LDS_WAIT();
        bf16_t* Og = P.AO + ((size_t)(b * SEQ) + qw0) * DM + 128 * hh;
#pragma unroll
        for (int it = 0; it < 8; ++it) { const int idx = it * 64 + lane, row = idx >> 4, ch = idx & 15;
            const u32x4 v = *(const LAS u32x4*)(stg + row * 272 + ch * 16); *(u32x4*)(Og + (size_t)row * DM + ch * 8) = v; }
    }
    __syncthreads();
}

__device__ __forceinline__ void sb_unit(const AttnP& P, int b, int h, int qb, LAS unsigned char* lds) {
    int tid = threadIdx.x; asm volatile("" : "+v"(tid)); const int lane = tid & 63, r32 = lane & 31, hi = lane >> 5;
    const int wid = __builtin_amdgcn_readfirstlane(tid >> 6);
    const int q0 = qb * 256, qw0 = q0 + 32 * wid, NT = 4 * (qb + 1);
    const bf16_t* Qg = P.Qs + ((size_t)(b * 8 + h) * SEQ + qw0 + r32) * 64;
    const unsigned char* Kg = (const unsigned char*)(P.Ks + (size_t)(b * 8 + h) * SEQ * 64) + tid * 16;
    const unsigned char* Vg = (const unsigned char*)(P.Vs + (size_t)(b * 8 + h) * SEQ * 64) + tid * 16;
    bf16x8 qf[4];
#pragma unroll
    for (int s = 0; s < 4; ++s) qf[s] = *(const bf16x8*)(Qg + 16 * s + 8 * hi);
    f16x8 atri[2], aone;
#pragma unroll
    for (int st = 0; st < 2; ++st)
#pragma unroll
        for (int jj = 0; jj < 8; ++jj) { const int j = 16 * st + 8 * (jj >> 2) + 4 * hi + (jj & 3); atri[st][jj] = (j >= r32) ? (_Float16)(-1.0f) : (_Float16)0.0f; }
#pragma unroll
    for (int jj = 0; jj < 8; ++jj) aone[jj] = (_Float16)(-1.0f);
    f32x16 o[2]; o[0] = f32x16{}; o[1] = f32x16{};
    f32x16 carry = f32x16{};
    const unsigned ldsw = (unsigned)wid * 1024u;
#define SLOAD(t) do { const int so_ = ((t) & 3) * 16384; const size_t go_ = (size_t)(NT - 1 - (t)) * 8192; GLDS16(Kg + go_, so_); GLDS16(Vg + go_, so_ + 8192); } while (0)
#define SQK(Z0, Z1, t) do { const LAS unsigned char* Kb_ = lds + ((t) & 3) * 16384 + hi * 1024 + r32 * 16; Z0 = f32x16{}; Z1 = f32x16{}; \
        _Pragma("unroll") for (int s = 0; s < 4; ++s) { \
            const bf16x8 a0 = *(const LAS bf16x8*)(Kb_ + s * 2048), a1 = *(const LAS bf16x8*)(Kb_ + s * 2048 + 512); \
            Z0 = __builtin_amdgcn_mfma_f32_32x32x16_bf16(a0, qf[s], Z0, 0, 0, 0); \
            Z1 = __builtin_amdgcn_mfma_f32_32x32x16_bf16(a1, qf[s], Z1, 0, 0, 0); } } while (0)
    const int jlast = (qw0 + 31) >> 6, tfirst = NT - 1 - jlast;
    LAS unsigned* ndone = (LAS unsigned*)(lds + 131072 + 512);
    if (tid == 0) *ndone = 0u;
    SLOAD(0); SLOAD(1); SLOAD(2);
    ATT_WAITBAR(4);
    f32x16 z0, z1, y0, y1;
    if (tfirst == 0) SQK(z0, z1, 0);
    const int vlane = ((lane >> 4) & 1) * 32 + (lane & 3) * 8 + (4 * hi + ((lane & 15) >> 2)) * 64;
#define SCAN(W, INC) do { f16x8 x0_, x1_; \
            _Pragma("unroll") for (int q = 0; q < 4; ++q) { const f16x2 t0_ = __builtin_bit_cast(f16x2, __builtin_amdgcn_cvt_pkrtz(W[2 * q], W[2 * q + 1])); x0_[2 * q] = t0_[0]; x0_[2 * q + 1] = t0_[1]; \
                const f16x2 t1_ = __builtin_bit_cast(f16x2, __builtin_amdgcn_cvt_pkrtz(W[8 + 2 * q], W[8 + 2 * q + 1])); x1_[2 * q] = t1_[0]; x1_[2 * q + 1] = t1_[1]; } \
            INC = __builtin_amdgcn_mfma_f32_32x32x16_f16(atri[0], x0_, carry, 0, 0, 0); \
            INC = __builtin_amdgcn_mfma_f32_32x32x16_f16(atri[1], x1_, INC, 0, 0, 0); \
            carry = __builtin_amdgcn_mfma_f32_32x32x16_f16(aone, x0_, carry, 0, 0, 0); \
            carry = __builtin_amdgcn_mfma_f32_32x32x16_f16(aone, x1_, carry, 0, 0, 0); } while (0)
#define SPV(A, BLK) do { _Pragma("unroll") for (int sp = 0; sp < 2; ++sp) { \
                u32x4 pw_; pw_.x = cvtpk(A[8 * sp + 0], A[8 * sp + 1]); pw_.y = cvtpk(A[8 * sp + 2], A[8 * sp + 3]); pw_.z = cvtpk(A[8 * sp + 4], A[8 * sp + 5]); pw_.w = cvtpk(A[8 * sp + 6], A[8 * sp + 7]); \
                const bf16x8 pf_ = __builtin_bit_cast(bf16x8, pw_); const int g_ = 2 * (BLK) + sp; \
                _Pragma("unroll") for (int d = 0; d < 2; ++d) { const bf16x8 vf_ = cat8(vtr(Vb + d * 4096 + g_ * 1024), vtr(Vb + d * 4096 + g_ * 1024 + 512)); \
                    o[d] = __builtin_amdgcn_mfma_f32_32x32x16_bf16(vf_, pf_, o[d], 0, 0, 0); } } } while (0)
#define SBODY(DIAG, NEXT, t) do { \
        const LAS unsigned char* Vb = lds + ((t) & 3) * 16384 + 8192 + vlane; \
        const int dq = qw0 + r32 - 64 * (NT - 1 - (t)); \
        if (NEXT) SQK(y0, y1, (t) + 1); \
        f32x16 w1_, w0_; \
        _Pragma("unroll") for (int r = 0; r < 16; ++r) { w1_[r] = __builtin_amdgcn_logf(1.0f + __builtin_amdgcn_exp2f(z1[r])); } \
        _Pragma("unroll") for (int r = 0; r < 16; ++r) { w0_[r] = __builtin_amdgcn_logf(1.0f + __builtin_amdgcn_exp2f(z0[r])); } \
        if (DIAG) { _Pragma("unroll") for (int r = 0; r < 16; ++r) { if (crow(r, hi) + 32 >= dq) w1_[r] = 0.f; if (crow(r, hi) >= dq) w0_[r] = 0.f; } } \
        f32x16 i1_, i0_; \
        SCAN(w1_, i1_); \
        SCAN(w0_, i0_); \
        _Pragma("unroll") for (int r = 0; r < 16; ++r) w1_[r] = __builtin_amdgcn_exp2f(z1[r] + i1_[r]); \
        if (DIAG) { _Pragma("unroll") for (int r = 0; r < 16; ++r) if (crow(r, hi) + 32 >= dq) w1_[r] = 0.f; } \
        SPV(w1_, 1); \
        _Pragma("unroll") for (int r = 0; r < 16; ++r) w0_[r] = __builtin_amdgcn_exp2f(z0[r] + i0_[r]); \
        if (DIAG) { _Pragma("unroll") for (int r = 0; r < 16; ++r) if (crow(r, hi) >= dq) w0_[r] = 0.f; } \
        SPV(w0_, 0); \
        if (NEXT) { z0 = y0; z1 = y1; } } while (0)
#define STOP(t) do { if ((t) + 2 < NT) ATT_WAITBAR(2); else ATT_WAITBAR(0); if ((t) + 3 < NT) SLOAD((t) + 3); } while (0)
    int t = 0; bool mydone = false;
    for (; t < tfirst; ++t) { STOP(t); if (t + 1 == tfirst) SQK(z0, z1, t + 1); }
    if (t + 1 < NT) { STOP(t); SBODY(true, true, t); ++t; mydone = __all(carry[0] <= -ZTHR);
        for (; t + 1 < NT && !mydone; ++t) { STOP(t); SBODY(false, true, t); mydone = __all(carry[0] <= -ZTHR); }
        if (!mydone) { STOP(t); SBODY(false, false, t); ++t; } }
    else { STOP(t); SBODY(true, false, t); ++t; }
    if (lane == 0) __hip_atomic_fetch_add(ndone, 1u, __ATOMIC_RELAXED, __HIP_MEMORY_SCOPE_WORKGROUP);
    for (; t < NT; ++t) { STOP(t); if (*(volatile LAS unsigned*)ndone == 8u) break; }
#undef SBODY
#undef STOP
#undef SCAN
#undef SPV
#undef SLOAD
#undef SQK
    ATT_WAITBAR(0);
    float ss = 0.f;
#pragma unroll
    for (int d = 0; d < 2; ++d)
#pragma unroll
        for (int r = 0; r < 16; ++r) ss += o[d][r] * o[d][r];
    ss = swap_add(ss);
    const float rr = __builtin_amdgcn_rsqf(ss * (1.0f / 64.0f) + EPS);
    LAS unsigned char* stg = lds + 65536 + wid * 4608;
#pragma unroll
    for (int d = 0; d < 2; ++d)
#pragma unroll
        for (int r = 0; r < 16; r += 2) { const int dd = 32 * d + crow(r, hi);
            *(LAS unsigned*)(stg + r32 * 144 + dd * 2) = cvtpk(o[d][r] * rr * P.sog[dd], o[d][r + 1] * rr * P.sog[dd + 1]); }
    LDS_WAIT();
    bf16_t* Og = P.AO + ((size_t)(b * SEQ) + qw0) * DM + 512 + 64 * h;
#pragma unroll
    for (int it = 0; it < 4; ++it) { const int idx = it * 64 + lane, row = idx >> 3, ch = idx & 7;
        const u32x4 v = *(const LAS u32x4*)(stg + row * 144 + ch * 16); *(u32x4*)(Og + (size_t)row * DM + ch * 8) = v; }
    __syncthreads();
}
#undef GLDS16
#undef ATT_WAITBAR
}

#ifndef MK_N_LAUNCHES
#define MK_N_LAUNCHES 1
#endif
constexpr int N_PHASES = 9;
struct Args { const float* in[23]; float* out; unsigned char* ws; int ph_lo, ph_hi; };

__device__ __forceinline__ void p0_transpose_item(const float* W, int K, int N, bf16_t* WT, int row_off, LAS float* scr, int item, int lane) {
    const int nblk = N / 32, kb = item / nblk, nb = item % nblk, k0 = 64 * kb, n0 = 32 * nb;
#pragma unroll 8
    for (int i = 0; i < 32; ++i) { const int kk = 2 * i + (lane >> 5); scr[kk * 33 + (lane & 31)] = W[(size_t)(k0 + kk) * N + n0 + (lane & 31)]; }
    LDS_WAIT(); asm volatile("" ::: "memory");
    const int c = lane & 7;
#pragma unroll
    for (int j = 0; j < 4; ++j) { const int n = (lane >> 3) + 8 * j; const LAS float* s = scr + (8 * c) * 33 + n;
        u32x4 o; o.x = pk2(s[0 * 33], s[1 * 33]); o.y = pk2(s[2 * 33], s[3 * 33]); o.z = pk2(s[4 * 33], s[5 * 33]); o.w = pk2(s[6 * 33], s[7 * 33]);
        *(u32x4*)(WT + (size_t)(row_off + n0 + n) * K + k0 + 8 * c) = o; }
    LDS_WAIT(); asm volatile("" ::: "memory");
}

__global__ void __launch_bounds__(NWAVES * 64, 2) mega_fwd(Args args) {
    extern __shared__ __attribute__((aligned(16))) unsigned char lds_raw[];
    LAS unsigned char* lds = (LAS unsigned char*)lds_raw;
    volatile LAS unsigned* MISC = (volatile LAS unsigned*)(lds + MISC_OFF);
    const int G = gridDim.x; const int bx = blockIdx.x;
#define PHASE_IDS() int tid = threadIdx.x; asm volatile("" : "+v"(tid)); const int lane = tid & 63, wave = __builtin_amdgcn_readfirstlane(tid >> 6); const int gw = vcu * NWAVES + wave, NGW = G * NWAVES; (void)lane; (void)gw; (void)NGW
    const int vcu = (G % 8 == 0) ? (bx % 8) * (G / 8) + bx / 8 : bx;
    unsigned char* ws = args.ws;
    unsigned* ctl = (unsigned*)(ws + WS_CTL);
    float* modv = (float*)(ws + WS_MODV);
    bf16_t* Wr_t = (bf16_t*)(ws + WS_WR); bf16_t* Win_t = (bf16_t*)(ws + WS_WIN); bf16_t* Wout_t = (bf16_t*)(ws + WS_WOUT);
    bf16_t* W13_t = (bf16_t*)(ws + WS_W13); bf16_t* W2_t = (bf16_t*)(ws + WS_W2); bf16_t* HB = (bf16_t*)(ws + WS_HB);
    bf16_t* AO = (bf16_t*)(ws + WS_AO); bf16_t* HG = (bf16_t*)(ws + WS_HG); bf16_t* Y = (bf16_t*)(ws + WS_Y);
    int* tokinfo = (int*)(ws + WS_ROUTE); int* list = (int*)(ws + WS_LIST); float* listw = (float*)(ws + WS_LISTW);
    const float* x = args.in[0]; float* out = args.out;

    for (int u = threadIdx.x; u < (LDS_BYTES - LDSCTL_OFF) / 4; u += NWAVES * 64) ((LAS unsigned*)(lds + LDSCTL_OFF))[u] = 0u;
    __syncthreads();
    XcdBarrier bar; bar.bar = ctl + CW_BAR; bar.x = 0; bar.st = nullptr;
    if (MK_N_LAUNCHES == 1) bar = xcd_barrier_post(ctl + CW_BAR, MISC + 8);
#ifdef TS_MASK
    LAS unsigned long long* tsb = (LAS unsigned long long*)(lds + LDSCTL_OFF + 12288);
    int tsn = 0;
#define TS_EV() do { if (blockIdx.x == 0 && threadIdx.x == 0) tsb[tsn] = __builtin_amdgcn_s_memrealtime(); ++tsn; } while (0)
#else
#define TS_EV() do {} while (0)
#endif
#define GRID_BAR() do { TS_EV(); if (MK_N_LAUNCHES == 1) xcd_barrier(bar); TS_EV(); } while (0)
    TS_EV();
    const int lo = args.ph_lo, hi = args.ph_hi;
#ifndef PHMASK
#define PHMASK 0x1ff
#endif
#define IN(k) ((((PHMASK) >> (k)) & 1) && lo <= (k) && (k) < hi)
#define BOTH(k) (IN(k) && IN((k) + 1))

#ifndef REP_P0
#define REP_P0 1
#endif
    for (int rep0 = 0; rep0 < REP_P0; ++rep0)
    if (IN(0)) {
        PHASE_IDS();
        for (int item = vcu; item < 192; item += G) {
            LAS float* sl = (LAS float*)lds;
            LAS float* red = (LAS float*)(lds + 8192);
            for (int i = tid; i < 2048; i += 512) { const float c = args.in[1][i]; sl[i] = c / (1.0f + __expf(-c)); }
            __syncthreads();
            const int n0 = 32 * item, col = lane & 31, kh = lane >> 5;
            const float* W = args.in[2] + n0 + col;
            float a0 = 0.f, a1 = 0.f;
#pragma unroll 16
            for (int i = 0; i < 64; ++i) { const int k = 128 * wave + 2 * i + kh; const float w = W[(size_t)k * 6144]; a0 += sl[k] * w; a1 += sl[1024 + k] * w; }
            a0 += __shfl_xor(a0, 32); a1 += __shfl_xor(a1, 32);
            if (lane < 32) { red[(wave * 2 + 0) * 32 + col] = a0; red[(wave * 2 + 1) * 32 + col] = a1; }
            __syncthreads();
            if (tid < 64) { const int b = tid >> 5, c2 = tid & 31; float v = 0.f;
#pragma unroll
                for (int w = 0; w < 8; ++w) v += red[(w * 2 + b) * 32 + c2];
                const int n = n0 + c2, j = n >> 10, k = n & 1023; v += args.in[3][n];
                if (j == 1) v = args.in[4][k] * (1.0f + v);
                if (j == 4) v = args.in[15][k] * (1.0f + v);
                modv[(b * 6 + j) * 1024 + k] = v; }
            __syncthreads();
        }
        if (vcu == G - 1) {
            for (int idx = tid; idx < 65536; idx += 512) { const int j = idx >> 10, k = idx & 1023; float v = 0.f;
                if (j < 4) v = args.in[16][k * 4 + j]; else if (j < 36) v = args.in[18][(size_t)((j - 4) >> 3) * 8192 + k * 8 + ((j - 4) & 7)];
                Wr_t[idx] = (bf16_t)f2bf(v); }
        }
        LAS float* scr = (LAS float*)(lds + wave * 16384);
        constexpr int I_IN = 16 * 96, I_OUT = 16 * 32, I_E = 128, NITEMS = I_IN + I_OUT + 3 * 32 * I_E;
        for (int it = gw; it < NITEMS; it += NGW) {
            int r = it;
            if (r < I_IN) { p0_transpose_item(args.in[5], 1024, 3072, Win_t, 0, scr, r, lane); continue; } r -= I_IN;
            if (r < I_OUT) { p0_transpose_item(args.in[14], 1024, 1024, Wout_t, 0, scr, r, lane); continue; } r -= I_OUT;
            if (r < 32 * I_E) { const int e = r / I_E; p0_transpose_item(args.in[20] + (size_t)e * 1024 * 256, 1024, 256, W13_t + (size_t)e * 512 * 1024, 0, scr, r % I_E, lane); continue; } r -= 32 * I_E;
            if (r < 32 * I_E) { const int e = r / I_E; p0_transpose_item(args.in[21] + (size_t)e * 1024 * 256, 1024, 256, W13_t + (size_t)e * 512 * 1024, 256, scr, r % I_E, lane); continue; } r -= 32 * I_E;
            { const int e = r / I_E; p0_transpose_item(args.in[22] + (size_t)e * 256 * 1024, 256, 1024, W2_t + (size_t)e * 1024 * 256, 0, scr, r % I_E, lane); }
        }
        if (BOTH(0)) GRID_BAR();
    }

#ifndef REP_P1
#define REP_P1 1
#endif
    for (int rep1 = 0; rep1 < REP_P1; ++rep1)
    if (IN(1)) {
        PHASE_IDS();
        for (int m0 = gw; m0 < MTOK; m0 += 2 * NGW) {
            const int m1 = m0 + NGW; const bool two = m1 < MTOK; const int mb = two ? m1 : m0;
            const f32x4* xa = (const f32x4*)(x + (size_t)m0 * DM) + lane; const f32x4* xb = (const f32x4*)(x + (size_t)mb * DM) + lane;
            f32x4 va[4], vb[4]; float sa = 0.f, sb = 0.f;
#pragma unroll
            for (int j = 0; j < 4; ++j) { va[j] = xa[64 * j]; vb[j] = xb[64 * j]; }
#pragma unroll
            for (int j = 0; j < 4; ++j) { sa += (va[j].x * va[j].x + va[j].y * va[j].y) + (va[j].z * va[j].z + va[j].w * va[j].w); sb += (vb[j].x * vb[j].x + vb[j].y * vb[j].y) + (vb[j].z * vb[j].z + vb[j].w * vb[j].w); }
#pragma unroll
            for (int o = 1; o < 64; o <<= 1) { sa += __shfl_xor(sa, o); sb += __shfl_xor(sb, o); }
            const float ra = __builtin_amdgcn_rsqf(sa * (1.f / DM) + EPS), rb = __builtin_amdgcn_rsqf(sb * (1.f / DM) + EPS);
            const int ba = m0 >> 13, bb = mb >> 13;
            const f32x4* gma = (const f32x4*)(modv + (ba * 6 + 1) * 1024) + lane; const f32x4* sha = (const f32x4*)(modv + (ba * 6 + 0) * 1024) + lane;
            const f32x4* gmb = (const f32x4*)(modv + (bb * 6 + 1) * 1024) + lane; const f32x4* shb = (const f32x4*)(modv + (bb * 6 + 0) * 1024) + lane;
            unsigned long long* oa = (unsigned long long*)(HB + (size_t)m0 * DM) + lane; unsigned long long* ob = (unsigned long long*)(HB + (size_t)mb * DM) + lane;
#pragma unroll
            for (int j = 0; j < 4; ++j) { const f32x4 ha = va[j] * ra * gma[64 * j] + sha[64 * j];
                oa[64 * j] = (unsigned long long)cvtpk(ha.x, ha.y) | ((unsigned long long)cvtpk(ha.z, ha.w) << 32); }
            if (two) {
#pragma unroll
                for (int j = 0; j < 4; ++j) { const f32x4 hb = vb[j] * rb * gmb[64 * j] + shb[64 * j];
                    ob[64 * j] = (unsigned long long)cvtpk(hb.x, hb.y) | ((unsigned long long)cvtpk(hb.z, hb.w) << 32); } }
        }
        if (BOTH(1)) GRID_BAR();
    }

#ifndef REP_P2
#define REP_P2 1
#endif
    for (int rep2 = 0; rep2 < REP_P2; ++rep2)
    if (IN(2)) {
        DenseSched S; S.nM = MTOK / 256; S.nN = INC / 256; S.nwg = S.nM * S.nN; S.G = G; S.c = bx; S.K = DM; S.A = (const char*)HB; S.B = (const char*)Win_t; S.bmode = 1; S.perm = true;
        EpiQKV E{(bf16_t*)(ws + WS_QD), (bf16_t*)(ws + WS_KD), (bf16_t*)(ws + WS_VD), (bf16_t*)(ws + WS_QS), (bf16_t*)(ws + WS_KS), (bf16_t*)(ws + WS_VS), args.in[6], args.in[7]};
        pg8::gemm_phase<EpiQKV, DenseSched, true>(lds + RING_OFF, DM, S, E);
        if (BOTH(2)) GRID_BAR();
    }

    if (IN(3)) {
        PHASE_IDS();
        att::AttnP P{(const bf16_t*)(ws + WS_QD), (const bf16_t*)(ws + WS_KD), (const bf16_t*)(ws + WS_VD), (const bf16_t*)(ws + WS_QS), (const bf16_t*)(ws + WS_KS), (const bf16_t*)(ws + WS_VS), AO,
                     args.in[6], args.in[7], args.in[8], args.in[9], args.in[10], args.in[11], args.in[12], args.in[13]};
        const float e1 = wave_sum(P.lq1[lane] * P.lk1[lane]), e2 = wave_sum(P.lq2[lane] * P.lk2[lane]);
        const float lam = __expf(e1) - __expf(e2) + LAMBDA_INIT;
        const float Mp = 8.0f * wave_max(fabsf(P.gq[lane])) * wave_max(fabsf(P.gk[lane])) * LOG2E;
        LAS unsigned* qslot = (LAS unsigned*)(lds + LDSCTL_OFF + 516);
#ifndef REP_ATT
#define REP_ATT 1
#endif
        for (int rep = 0; rep < REP_ATT; ++rep)
        for (;;) {
            if (tid == 0) *qslot = atomicAdd(ctl + CW_QUEUE + rep, 1u);
            __syncthreads();
            const int u = (int)*(volatile LAS unsigned*)qslot;
            if (u >= 1024) break;
            if (u < 512) { const int g2 = u >> 8, r = u & 255, iq = 63 - (r >> 2), hs = (r >> 1) & 1, b = r & 1, hh = g2 == 0 ? 3 - hs : 1 - hs; att::diff_unit(P, b, hh, iq, lds, lam, Mp); }
            else { const int s = u - 512, qb = 31 - (s >> 4), bh = s & 15; att::sb_unit(P, bh >> 3, bh & 7, qb, lds); }
        }
        if (BOTH(3)) GRID_BAR();
    }

#ifndef REP_P4
#define REP_P4 1
#endif
    for (int rep4 = 0; rep4 < REP_P4; ++rep4)
    if (IN(4)) {
        DenseSched S; S.nM = MTOK / 256; S.nN = DM / 256; S.nwg = S.nM * S.nN; S.G = G; S.c = bx; S.K = DM; S.A = (const char*)AO; S.B = (const char*)Wout_t; S.bmode = 0; S.perm = true;
        EpiX1 E{x, out, modv + 2 * 1024};
        pg8::gemm_phase<EpiX1, DenseSched, false>(lds + RING_OFF, DM, S, E);
        if (BOTH(4)) GRID_BAR();
    }

    if (IN(5)) {
        PHASE_IDS();
        LAS unsigned char* At = lds;
        LAS float* red = (LAS float*)(lds + 66560);
        for (int T = vcu; T < MTOK / 32; T += G) {
            const int row0 = T * 32, b = row0 >> 13;
            {
                const f32x4* gm = (const f32x4*)(modv + (b * 6 + 4) * 1024) + lane; const f32x4* sh = (const f32x4*)(modv + (b * 6 + 3) * 1024) + lane;
                f32x4 v[4][4]; float s[4];
#pragma unroll
                for (int rr = 0; rr < 4; ++rr) { const f32x4* xr = (const f32x4*)(out + (size_t)(row0 + 4 * wave + rr) * DM) + lane;
#pragma unroll
                    for (int j = 0; j < 4; ++j) v[rr][j] = xr[64 * j]; }
                f32x4 g[4], t[4];
#pragma unroll
                for (int j = 0; j < 4; ++j) { g[j] = gm[64 * j]; t[j] = sh[64 * j]; }
#pragma unroll
                for (int rr = 0; rr < 4; ++rr) { s[rr] = 0.f;
#pragma unroll
                    for (int j = 0; j < 4; ++j) s[rr] += (v[rr][j].x * v[rr][j].x + v[rr][j].y * v[rr][j].y) + (v[rr][j].z * v[rr][j].z + v[rr][j].w * v[rr][j].w); }
#pragma unroll
                for (int o = 1; o < 64; o <<= 1) {
#pragma unroll
                    for (int rr = 0; rr < 4; ++rr) s[rr] += __shfl_xor(s[rr], o); }
#pragma unroll
                for (int rr = 0; rr < 4; ++rr) { const int rl = 4 * wave + rr, m = row0 + rl; const float rstd = __builtin_amdgcn_rsqf(s[rr] * (1.f / DM) + EPS);
                    unsigned long long* o8 = (unsigned long long*)(HB + (size_t)m * DM) + lane;
#pragma unroll
                    for (int j = 0; j < 4; ++j) { const f32x4 hq = v[rr][j] * rstd * g[j] + t[j];
                        const unsigned long long pk = (unsigned long long)cvtpk(hq.x, hq.y) | ((unsigned long long)cvtpk(hq.z, hq.w) << 32);
                        o8[64 * j] = pk; *(LAS unsigned long long*)(At + rl * 2064 + (4 * lane + 256 * j) * 2) = pk; } }
            }
            __syncthreads();
            {
                f32x4 acc[2][3];
#pragma unroll
                for (int mf = 0; mf < 2; ++mf)
#pragma unroll
                    for (int nf = 0; nf < 3; ++nf) acc[mf][nf] = (f32x4){0.f, 0.f, 0.f, 0.f};
                const int fr = lane & 15, fq = lane >> 4;
#pragma unroll
                for (int ks = 0; ks < 4; ++ks) {
                    const int k0 = 128 * wave + 32 * ks + 8 * fq;
                    bf16x8 af[2], bfm[3];
#pragma unroll
                    for (int mf = 0; mf < 2; ++mf) af[mf] = *(const LAS bf16x8*)(At + (16 * mf + fr) * 2064 + k0 * 2);
#pragma unroll
                    for (int nf = 0; nf < 3; ++nf) bfm[nf] = *(const bf16x8*)(Wr_t + (size_t)(16 * nf + fr) * 1024 + k0);
#pragma unroll
                    for (int mf = 0; mf < 2; ++mf)
#pragma unroll
                        for (int nf = 0; nf < 3; ++nf) acc[mf][nf] = __builtin_amdgcn_mfma_f32_16x16x32_bf16(af[mf], bfm[nf], acc[mf][nf], 0, 0, 0);
                }
#pragma unroll
                for (int mf = 0; mf < 2; ++mf)
#pragma unroll
                    for (int nf = 0; nf < 3; ++nf)
#pragma unroll
                        for (int i = 0; i < 4; ++i) red[(wave * 32 + 16 * mf + 4 * fq + i) * 49 + 16 * nf + fr] = acc[mf][nf][i];
            }
            __syncthreads();
            if (tid < 32) {
                const int m = row0 + tid;
                float gl[4];
#pragma unroll
                for (int c = 0; c < 4; ++c) { float v = args.in[17][c];
#pragma unroll
                    for (int w = 0; w < 8; ++w) v += red[(w * 32 + tid) * 49 + c]; gl[c] = v; }
                int gs = 0; float gmax = gl[0];
#pragma unroll
                for (int c = 1; c < 4; ++c) if (gl[c] > gmax) { gmax = gl[c]; gs = c; }
                float den = 0.f;
#pragma unroll
                for (int c = 0; c < 4; ++c) den += __expf(gl[c] - gmax);
                const float gate = 1.0f / den;
                float el[8];
#pragma unroll
                for (int e = 0; e < 8; ++e) { float v = args.in[19][gs * 8 + e];
#pragma unroll
                    for (int w = 0; w < 8; ++w) v += red[(w * 32 + tid) * 49 + 4 + gs * 8 + e]; el[e] = v; }
                int e0 = 0; float t0 = el[0];
#pragma unroll
                for (int e = 1; e < 8; ++e) if (el[e] > t0) { t0 = el[e]; e0 = e; }
                int e1 = -1; float t1 = -INFINITY;
#pragma unroll
                for (int e = 0; e < 8; ++e) if (e != e0 && el[e] > t1) { t1 = el[e]; e1 = e; }
                const float w0 = 1.0f / (1.0f + __expf(t1 - t0)), w1 = 1.0f - w0;
                const int ge0 = gs * 8 + e0, ge1 = gs * 8 + e1;
                volatile LAS unsigned* ecnt = (volatile LAS unsigned*)(lds + 120832); volatile LAS unsigned* ebase = ecnt + 32;
                ecnt[tid] = 0u;
                const int l0 = (int)__hip_atomic_fetch_add((LAS unsigned*)ecnt + ge0, 1u, __ATOMIC_RELAXED, __HIP_MEMORY_SCOPE_WAVEFRONT);
                const int l1 = (int)__hip_atomic_fetch_add((LAS unsigned*)ecnt + ge1, 1u, __ATOMIC_RELAXED, __HIP_MEMORY_SCOPE_WAVEFRONT);
                const unsigned mine = ecnt[tid];
                if (mine) ebase[tid] = atomicAdd(ctl + CW_CNT + 64 * tid, mine);
                const int p0 = (int)ebase[ge0] + l0, p1 = (int)ebase[ge1] + l1;
                list[ge0 * MTOK + p0] = m; listw[ge0 * MTOK + p0] = gate * w0;
                list[ge1 * MTOK + p1] = m; listw[ge1 * MTOK + p1] = gate * w1;
                *(int4*)(tokinfo + 4 * m) = make_int4(ge0, p0, ge1, p1);
            }
            __syncthreads();
        }
        if (BOTH(5)) GRID_BAR();
    }

    LAS int* tpre = (LAS int*)(lds + TPRE_OFF); LAS int* cnts = tpre + 64;
    if (IN(6) || IN(7) || IN(8)) {
        if (threadIdx.x < 64) { const int e = threadIdx.x & 31; const int c = (int)__hip_atomic_load(ctl + CW_CNT + 64 * e, RLX_AGENT); const int nt_ = (c + 255) >> 8; int inc = nt_;
#pragma unroll
            for (int o = 1; o < 32; o <<= 1) { const int v = __shfl_up(inc, o, 32); if (e >= o) inc += v; }
            if (threadIdx.x < 32) { cnts[e] = c; tpre[e] = inc - nt_; if (e == 31) tpre[32] = inc; } }
        __syncthreads();
    }
#ifndef REP_P6
#define REP_P6 1
#endif
    for (int rep6 = 0; rep6 < REP_P6; ++rep6)
    if (IN(6)) {
        MoeUpSched S{G, bx, tpre, cnts, list, (const char*)HB, (const char*)W13_t};
        EpiAct E{HG, listw};
        pg8::gemm_phase<EpiAct, MoeUpSched, false>(lds + RING_OFF, DM, S, E);
        if (BOTH(6)) GRID_BAR();
    }
#ifndef REP_P7
#define REP_P7 1
#endif
    for (int rep7 = 0; rep7 < REP_P7; ++rep7)
    if (IN(7)) {
        MoeDownSched S{G, bx, tpre, (const char*)HG, (const char*)W2_t};
        EpiY E{Y};
        pg8::gemm_phase<EpiY, MoeDownSched, false>(lds + RING_OFF, DEXP, S, E);
        if (BOTH(7)) GRID_BAR();
    }
    if (IN(8)) {
        PHASE_IDS();
        int tb = 0; if (lane < 32) tb = tpre[lane] * 256;
        for (int m0 = gw; m0 < MTOK; m0 += 2 * NGW) {
            const int m1 = (m0 + NGW < MTOK) ? m0 + NGW : m0; const bool two = m1 != m0;
            const int4 ia = *(const int4*)(tokinfo + 4 * m0), ib = *(const int4*)(tokinfo + 4 * m1);
            const int sa0 = __shfl(tb, ia.x) + ia.y, sa1 = __shfl(tb, ia.z) + ia.w, sb0 = __shfl(tb, ib.x) + ib.y, sb1 = __shfl(tb, ib.z) + ib.w;
            f32x4* oa = (f32x4*)(out + (size_t)m0 * DM) + lane; f32x4* ob = (f32x4*)(out + (size_t)m1 * DM) + lane;
            const f32x4* gta = (const f32x4*)(modv + ((m0 >> 13) * 6 + 5) * 1024) + lane; const f32x4* gtb = (const f32x4*)(modv + ((m1 >> 13) * 6 + 5) * 1024) + lane;
            const u32x2* ya0 = (const u32x2*)(Y + (size_t)sa0 * DM) + lane; const u32x2* ya1 = (const u32x2*)(Y + (size_t)sa1 * DM) + lane;
            const u32x2* yb0 = (const u32x2*)(Y + (size_t)sb0 * DM) + lane; const u32x2* yb1 = (const u32x2*)(Y + (size_t)sb1 * DM) + lane;
            u32x2 a0[4], a1[4], b0[4], b1[4]; f32x4 xa[4], xb[4];
#pragma unroll
            for (int j = 0; j < 4; ++j) { a0[j] = ya0[64 * j]; a1[j] = ya1[64 * j]; b0[j] = yb0[64 * j]; b1[j] = yb1[64 * j]; xa[j] = oa[64 * j]; xb[j] = ob[64 * j]; }
#define YSUM(A, C) (f32x4){__uint_as_float((A).x << 16) + __uint_as_float((C).x << 16), __uint_as_float((A).x & 0xffff0000u) + __uint_as_float((C).x & 0xffff0000u), \
                           __uint_as_float((A).y << 16) + __uint_as_float((C).y << 16), __uint_as_float((A).y & 0xffff0000u) + __uint_as_float((C).y & 0xffff0000u)}
#pragma unroll
            for (int j = 0; j < 4; ++j) oa[64 * j] = xa[j] + gta[64 * j] * YSUM(a0[j], a1[j]);
            if (two) {
#pragma unroll
                for (int j = 0; j < 4; ++j) ob[64 * j] = xb[j] + gtb[64 * j] * YSUM(b0[j], b1[j]); }
#undef YSUM
        }
    }
#ifdef TS_MASK
    TS_EV();
    if (blockIdx.x == 0 && threadIdx.x == 0) { unsigned long long tot = 0; for (int i = 0; i + 1 < tsn; ++i) if ((TS_MASK >> i) & 1u) tot += tsb[i + 1] - tsb[i];
        const unsigned long long t0 = __builtin_amdgcn_s_memrealtime(); while (__builtin_amdgcn_s_memrealtime() - t0 < tot) __builtin_amdgcn_s_sleep(8); }
#endif
#undef IN
#undef BOTH
#undef GRID_BAR
}

extern "C" void kernel_launch(void* const* d_in, const int* in_sizes, int n_in, void* d_out, int out_size, void* d_ws, size_t ws_size, hipStream_t stream) {
    static int grid = 0;
    if (grid == 0) {
        if (n_in != 23 || out_size != MTOK * DM || ws_size < WS_END) { fprintf(stderr, "kernel_launch: unexpected shapes (n_in %d out %d ws %zu)\n", n_in, out_size, ws_size); grid = -1; return; }
        int dev = 0, cus = 0, per_cu = 0;
        if (hipGetDevice(&dev) != hipSuccess || hipDeviceGetAttribute(&cus, hipDeviceAttributeMultiprocessorCount, dev) != hipSuccess) { grid = -1; return; }
        if (hipFuncSetAttribute((const void*)mega_fwd, hipFuncAttributeMaxDynamicSharedMemorySize, LDS_BYTES) != hipSuccess) { fprintf(stderr, "kernel_launch: hipFuncSetAttribute failed\n"); grid = -1; return; }
        if (hipOccupancyMaxActiveBlocksPerMultiprocessor(&per_cu, (const void*)mega_fwd, NWAVES * 64, LDS_BYTES) != hipSuccess || per_cu < 1) fprintf(stderr, "kernel_launch: occupancy query reports %d\n", per_cu);
        (void)hipGetLastError();
        grid = cus;
    }
    if (grid < 0) return;
    if (hipMemsetAsync((char*)d_ws + WS_CTL, 0, CTL_ZERO_BYTES, stream) != hipSuccess) return;
    Args a{};
    for (int i = 0; i < 23; ++i) a.in[i] = (const float*)d_in[i];
    a.out = (float*)d_out; a.ws = (unsigned char*)d_ws;
    if (MK_N_LAUNCHES == 1) { a.ph_lo = 0; a.ph_hi = N_PHASES; hipLaunchKernelGGL(mega_fwd, dim3(grid), dim3(NWAVES * 64), LDS_BYTES, stream, a); }
    else for (int p = 0; p < N_PHASES; ++p) { a.ph_lo = p; a.ph_hi = p + 1; hipLaunchKernelGGL(mega_fwd, dim3(grid), dim3(NWAVES * 64), LDS_BYTES, stream, a); }
}
```
